# Optimizing an MI355X kernel written in HIP

```python
import math
import jax, jax.numpy as jnp
from jax import lax
import numpy as np

D_MODEL = 2048
BATCH = 4
SEQ = 4096
DEPTH = 1

N_META = 16
MIX_WIDTH = D_MODEL
RET_WIDTH = MIX_WIDTH // 2
DIFF_WIDTH = MIX_WIDTH - RET_WIDTH
RET_HEADS = 4
RET_V_DIM = RET_WIDTH // RET_HEADS
RET_QK_DIM = RET_V_DIM // 2
DIFF_HEADS = 4
DIFF_V_DIM = DIFF_WIDTH // DIFF_HEADS
DIFF_QK_DIM = DIFF_V_DIM // 2
CHUNK = 128
Q_BLOCK = 128
N_EXPERTS = 32
TOP_K = 4
D_FF = D_MODEL
SWIGLU_ALPHA = 1.702
SWIGLU_LIMIT = 7.0
EXPERT_BLOCK = 512
NORM_EPS = 1e-6
RET_DECAY_BASE = 5.0
IN_SIZES = (RET_HEADS * RET_QK_DIM, RET_HEADS * RET_QK_DIM, RET_WIDTH, RET_WIDTH,
            DIFF_HEADS * 2 * DIFF_QK_DIM, DIFF_HEADS * 2 * DIFF_QK_DIM, DIFF_WIDTH)
IN_COLS = sum(IN_SIZES)

kernel_name = "hymba_retention_diffattn_moe_encoder"


def _rms(x, gain):
    xf = x.astype(jnp.float32)
    y = xf * lax.rsqrt(jnp.mean(xf * xf, axis=-1, keepdims=True) + NORM_EPS)
    return (y * gain.astype(jnp.float32)).astype(x.dtype)


def _alibi_slopes(n_heads):
    return jnp.exp2(-8.0 * jnp.arange(1, n_heads + 1, dtype=jnp.float32) / n_heads)


def _retention_one_way(q, k, v, log_gamma, strict):
    B, H, Lp, dk = q.shape
    dv = v.shape[-1]
    N = Lp // CHUNK
    qc = q.reshape(B, H, N, CHUNK, dk)
    kc = k.reshape(B, H, N, CHUNK, dk)
    vc = v.reshape(B, H, N, CHUNK, dv)
    pos = jnp.arange(CHUNK, dtype=jnp.float32)
    lg = log_gamma[:, None]
    rel = pos[:, None] - pos[None, :]
    visible = (rel > 0) if strict else (rel >= 0)
    decay_in = jnp.where(visible[None], jnp.exp(lg[:, :, None] * jnp.maximum(rel, 0.0)[None]), 0.0)
    scores = jnp.einsum('bhnid,bhnjd->bhnij', qc, kc) * decay_in[None, :, None]
    inner = jnp.einsum('bhnij,bhnje->bhnie', scores, vc)
    k_dec = kc * jnp.exp(lg * (CHUNK - 1 - pos))[None, :, None, :, None]
    kv = jnp.einsum('bhncd,bhnce->bhnde', k_dec, vc)
    chunk_decay = jnp.exp(lg * CHUNK)[None, :, :, None]

    def step(state, kv_n):
        return state * chunk_decay + kv_n, state

    s0 = jnp.zeros((B, H, dk, dv), kv.dtype)
    _, s_prev = lax.scan(step, s0, jnp.moveaxis(kv, 2, 0))
    s_prev = jnp.moveaxis(s_prev, 0, 2)
    q_dec = qc * jnp.exp(lg * (pos + 1.0))[None, :, None, :, None]
    cross = jnp.einsum('bhncd,bhnde->bhnce', q_dec, s_prev)
    return (inner + cross).reshape(B, H, Lp, dv)


def _bidir_retention(q, k, v, p_fwd, p_bwd):
    L = q.shape[2]
    pad = (-L) % CHUNK
    padw = ((0, 0), (0, 0), (pad, 0), (0, 0))
    q, k, v = (jnp.pad(t, padw) for t in (q, k, v))
    lg_f = jnp.log1p(-jnp.exp2(-p_fwd.astype(jnp.float32)))
    lg_b = jnp.log1p(-jnp.exp2(-p_bwd.astype(jnp.float32)))
    fwd = _retention_one_way(q, k, v, lg_f, strict=False)
    flip = lambda t: jnp.flip(t, axis=2)
    bwd = flip(_retention_one_way(flip(q), flip(k), flip(v), lg_b, strict=True))
    return (fwd + bwd)[:, :, pad:]


def _diff_attention(q, k, v, lam):
    B, L, H, _, d = q.shape
    pad = (-L) % Q_BLOCK
    nb = (L + pad) // Q_BLOCK
    qp = jnp.pad(q, ((0, 0), (pad, 0), (0, 0), (0, 0), (0, 0)))
    qb = qp.reshape(B, nb, Q_BLOCK, H, 2, d).transpose(1, 0, 2, 3, 4, 5)
    q_start = jnp.arange(nb) * Q_BLOCK - pad
    pos_k = jnp.arange(L)
    key_real = pos_k >= N_META
    slopes = _alibi_slopes(H)

    def one_block(args):
        qblk, start = args
        pos_q = start + jnp.arange(Q_BLOCK)
        dist = jnp.abs(pos_q[:, None] - pos_k[None, :]).astype(jnp.float32)
        both_real = (pos_q >= N_META)[:, None] & key_real[None, :]
        bias = -slopes[:, None, None] * jnp.where(both_real, dist, 0.0)[None]
        s = jnp.einsum('bqhmd,bkhmd->bhmqk', qblk, k).astype(jnp.float32) + bias[None, :, None]
        p = jax.nn.softmax(s, axis=-1)
        a = p[:, :, 0] - lam * p[:, :, 1]
        return jnp.einsum('bhqk,bkhe->bqhe', a.astype(v.dtype), v)

    out = lax.map(one_block, (qb, q_start))
    out = out.transpose(1, 0, 2, 3, 4).reshape(B, nb * Q_BLOCK, H, v.shape[-1])
    return out[:, pad:]


def _mixer(h, norm_gain, w_in, decay_f, decay_b, ret_gain, q_gain, k_gain,
           lq1, lk1, lq2, lk2, diff_gain, w_out, layer_idx):
    B, L, _ = h.shape
    u = _rms(h, norm_gain)
    z = u @ w_in
    split_at = [int(i) for i in np.cumsum(IN_SIZES)[:-1]]
    rq, rk, rv, rg, dq, dk, dv = jnp.split(z, split_at, axis=-1)
    rq = rq.reshape(B, L, RET_HEADS, RET_QK_DIM).transpose(0, 2, 1, 3)
    rk = rk.reshape(B, L, RET_HEADS, RET_QK_DIM).transpose(0, 2, 1, 3) * (RET_QK_DIM ** -0.5)
    rv = rv.reshape(B, L, RET_HEADS, RET_V_DIM).transpose(0, 2, 1, 3)
    ret = _bidir_retention(rq, rk, rv, decay_f, decay_b).transpose(0, 2, 1, 3)
    ret = _rms(ret, ret_gain.reshape(RET_HEADS, RET_V_DIM)).reshape(B, L, RET_WIDTH)
    ret = ret * jax.nn.silu(rg)
    lam_init = 0.8 - 0.6 * math.exp(-0.3 * layer_idx)
    lam = (jnp.exp(jnp.sum(lq1.astype(jnp.float32) * lk1.astype(jnp.float32)))
           - jnp.exp(jnp.sum(lq2.astype(jnp.float32) * lk2.astype(jnp.float32))) + lam_init)
    dq = _rms(dq.reshape(B, L, DIFF_HEADS, 2, DIFF_QK_DIM), q_gain) * (DIFF_QK_DIM ** -0.5)
    dk = _rms(dk.reshape(B, L, DIFF_HEADS, 2, DIFF_QK_DIM), k_gain)
    dv = dv.reshape(B, L, DIFF_HEADS, DIFF_V_DIM)
    att = _diff_attention(dq, dk, dv, lam)
    att = (_rms(att, diff_gain.reshape(DIFF_HEADS, DIFF_V_DIM)) * (1.0 - lam_init)).reshape(B, L, DIFF_WIDTH)
    y = jnp.concatenate([ret.astype(h.dtype), att.astype(h.dtype)], axis=-1) @ w_out
    return y.astype(h.dtype)


def _moe(h, norm_gain, w_router, b_router, w_gate_up, b_gate_up, w_down, b_down):
    B, L, D = h.shape
    T = B * L
    xt = _rms(h, norm_gain).reshape(T, D)
    logits = (xt @ w_router + b_router).astype(jnp.float32)
    top_val, top_idx = lax.top_k(logits, TOP_K)
    gates = jax.nn.softmax(top_val, axis=-1)
    P = T * TOP_K
    flat_e = top_idx.reshape(P)
    flat_tok = jnp.arange(P) // TOP_K
    flat_g = gates.reshape(P)
    order = jnp.argsort(flat_e)
    se, stok, sg = flat_e[order], flat_tok[order], flat_g[order]
    counts = jnp.bincount(flat_e, length=N_EXPERTS)
    starts = jnp.cumsum(counts) - counts
    padded = (counts + EXPERT_BLOCK - 1) // EXPERT_BLOCK * EXPERT_BLOCK
    pend = jnp.cumsum(padded)
    pstarts = pend - padded
    dest = pstarts[se] + (jnp.arange(P) - starts[se])
    n_blocks = -(-P // EXPERT_BLOCK) + N_EXPERTS
    cap = n_blocks * EXPERT_BLOCK
    buf_tok = jnp.full((cap,), T, jnp.int32).at[dest].set(stok.astype(jnp.int32))
    buf_g = jnp.zeros((cap,), jnp.float32).at[dest].set(sg)
    block_e = jnp.minimum(jnp.searchsorted(pend, jnp.arange(n_blocks) * EXPERT_BLOCK, side='right'),
                          N_EXPERTS - 1)
    x_pad = jnp.concatenate([xt, jnp.zeros((1, D), xt.dtype)], axis=0)
    xb = x_pad[buf_tok].reshape(n_blocks, EXPERT_BLOCK, D)

    def expert_block(args):
        xblk, e = args
        gu = xblk @ w_gate_up[e] + b_gate_up[e]
        gate = jnp.minimum(gu[:, :D_FF], SWIGLU_LIMIT)
        up = jnp.clip(gu[:, D_FF:], -SWIGLU_LIMIT, SWIGLU_LIMIT)
        glu = gate * jax.nn.sigmoid(SWIGLU_ALPHA * gate)
        return ((up + 1.0) * glu) @ w_down[e] + b_down[e]

    out = lax.map(expert_block, (xb, block_e)).reshape(cap, D)
    y = jax.ops.segment_sum(out * buf_g[:, None].astype(out.dtype), buf_tok, num_segments=T + 1)[:T]
    return y.reshape(B, L, D).astype(h.dtype)


def setup_inputs(seed: int = 0) -> dict:
    key = jax.random.key(seed)
    ks = jax.random.split(key, 24)
    f32 = jnp.float32
    nrm = lambda k, shape, scale: scale * jax.random.normal(k, shape, f32)
    Dp = DEPTH
    heads_p = jnp.arange(RET_HEADS, dtype=f32)
    return {
        "x": nrm(ks[0], (BATCH, SEQ, D_MODEL), 1.0),
        "meta_tokens": nrm(ks[1], (N_META, D_MODEL), 1.0),
        "attn_norm_gain": 1.0 + nrm(ks[2], (Dp, D_MODEL), 0.02),
        "w_in": nrm(ks[3], (Dp, D_MODEL, IN_COLS), D_MODEL ** -0.5),
        "ret_decay_fwd": RET_DECAY_BASE + heads_p[None] + nrm(ks[4], (Dp, RET_HEADS), 0.1),
        "ret_decay_bwd": RET_DECAY_BASE + heads_p[None] + nrm(ks[5], (Dp, RET_HEADS), 0.1),
        "ret_out_gain": 1.0 + nrm(ks[6], (Dp, RET_WIDTH), 0.02),
        "diff_q_gain": 1.0 + nrm(ks[7], (Dp, DIFF_QK_DIM), 0.02),
        "diff_k_gain": 1.0 + nrm(ks[8], (Dp, DIFF_QK_DIM), 0.02),
        "diff_lambda_q1": nrm(ks[9], (Dp, DIFF_QK_DIM), 0.1),
        "diff_lambda_k1": nrm(ks[10], (Dp, DIFF_QK_DIM), 0.1),
        "diff_lambda_q2": nrm(ks[11], (Dp, DIFF_QK_DIM), 0.1),
        "diff_lambda_k2": nrm(ks[12], (Dp, DIFF_QK_DIM), 0.1),
        "diff_out_gain": 1.0 + nrm(ks[13], (Dp, DIFF_WIDTH), 0.02),
        "w_out": nrm(ks[14], (Dp, MIX_WIDTH, D_MODEL), MIX_WIDTH ** -0.5),
        "ffn_norm_gain": 1.0 + nrm(ks[15], (Dp, D_MODEL), 0.02),
        "w_router": nrm(ks[16], (Dp, D_MODEL, N_EXPERTS), D_MODEL ** -0.5),
        "b_router": nrm(ks[17], (Dp, N_EXPERTS), 0.01),
        "w_gate_up": nrm(ks[18], (Dp, N_EXPERTS, D_MODEL, 2 * D_FF), D_MODEL ** -0.5),
        "b_gate_up": nrm(ks[19], (Dp, N_EXPERTS, 2 * D_FF), 0.01),
        "w_down": nrm(ks[20], (Dp, N_EXPERTS, D_FF, D_MODEL), D_FF ** -0.5),
        "b_down": nrm(ks[21], (Dp, N_EXPERTS, D_MODEL), 0.01),
    }


def reference(x, meta_tokens, attn_norm_gain, w_in, ret_decay_fwd, ret_decay_bwd, ret_out_gain,
              diff_q_gain, diff_k_gain, diff_lambda_q1, diff_lambda_k1, diff_lambda_q2, diff_lambda_k2,
              diff_out_gain, w_out, ffn_norm_gain, w_router, b_router, w_gate_up, b_gate_up,
              w_down, b_down):
    B, S, D = x.shape
    meta = jnp.broadcast_to(meta_tokens.astype(x.dtype)[None], (B, N_META, D))
    h = jnp.concatenate([meta, x], axis=1)
    for l in range(DEPTH):
        h = h + _mixer(h, attn_norm_gain[l], w_in[l], ret_decay_fwd[l], ret_decay_bwd[l], ret_out_gain[l],
                       diff_q_gain[l], diff_k_gain[l], diff_lambda_q1[l], diff_lambda_k1[l],
                       diff_lambda_q2[l], diff_lambda_k2[l], diff_out_gain[l], w_out[l], l)
        h = h + _moe(h, ffn_norm_gain[l], w_router[l], b_router[l], w_gate_up[l], b_gate_up[l],
                     w_down[l], b_down[l])
    return h[:, N_META:]
```

```cpp
#include <hip/hip_runtime.h>
#include <cstdio>
#include <cstdint>

#ifndef MK_SPLIT
#define MK_SPLIT 0
#endif

#ifndef ATT_V2
#define ATT_V2 1
#endif
#ifndef Y_FP8
#define Y_FP8 1
#endif
#ifndef MOE_FP8
#define MOE_FP8 1
#endif
#define GAS __attribute__((address_space(1)))
#define LAS __attribute__((address_space(3)))
typedef unsigned short bf16;
typedef unsigned v4u __attribute__((ext_vector_type(4)));
typedef unsigned v2u __attribute__((ext_vector_type(2)));
typedef float f32x2 __attribute__((ext_vector_type(2)));
typedef float f32x4 __attribute__((ext_vector_type(4)));
typedef float f32x8 __attribute__((ext_vector_type(8)));
typedef float f32x16 __attribute__((ext_vector_type(16)));
typedef short bf16x8 __attribute__((ext_vector_type(8)));
typedef short s16x4 __attribute__((ext_vector_type(4)));
typedef GAS unsigned gu32;

constexpr int BATCH = 4, SEQ = 4096, DM = 2048, NMETA = 16;
constexpr int T = BATCH * SEQ;
constexpr int TM = T + 256;
constexpr int NIN = 6144;
constexpr int C_RQ = 0, C_RK = 512, C_RV = 1024, C_RG = 2048, C_DQ = 3072, C_DK = 4096, C_DV = 5120;
constexpr int NE = 32, TOPK = 4, DFF = 2048;
constexpr int ECAP = T;
constexpr int MAXTILES = (T * TOPK) / 256 + NE;
constexpr float EPS = 1e-6f;
constexpr float LAM_INIT = 0.2f;
constexpr int NPHASE = 10;

constexpr size_t MiB = 1u << 20;
constexpr size_t WS_CTL = 0, CTL_ZERO_BYTES = 1 * MiB;
constexpr size_t WS_WIN = 1 * MiB;
constexpr size_t WS_WOUT = 25 * MiB;
constexpr size_t WS_WGU = 33 * MiB;
constexpr size_t WS_WD = 545 * MiB;
constexpr size_t WS_U = 801 * MiB;
constexpr size_t WS_Z = 866 * MiB;
constexpr size_t WS_KVS = 1062 * MiB;
constexpr size_t WS_META = WS_KVS + 128 * MiB;
constexpr size_t WS_OBUF = 1191 * MiB;
constexpr size_t WS_OBUF2 = WS_OBUF + 64 * MiB;
constexpr size_t WS_LSE = 1454 * MiB;
constexpr size_t WS_MIX = 1319 * MiB;
constexpr size_t WS_XT = 1383 * MiB;
constexpr size_t WS_TOK = 1447 * MiB;
constexpr size_t WS_GATE = 1449 * MiB;
constexpr size_t WS_RS = 1451 * MiB;
constexpr size_t WS_SLOT = 1453 * MiB;
constexpr size_t WS_ACT = 1455 * MiB;
constexpr size_t WS_Y = 1743 * MiB;
constexpr size_t WS_END = 2031 * MiB;
constexpr int CW_TMO = 0;
constexpr int CW_BAR = 4096;
constexpr int CW_CNT = 16384;
constexpr int CW_CONV = 28672;
constexpr int CW_ATT = 24576;
constexpr int CW_Q1 = 20480;
#ifndef NCONV
#define CONV_P1 0
#define CONV_P2 0
#define CONV_P3 47
#define CONV_P4 94
#define CONV_SPLIT3 ((CONV_TICKETS * CONV_P3) / 100)
#define CONV_SPLIT4 ((CONV_TICKETS * CONV_P4) / 100)
#define CONV_SPLIT ((CONV_TICKETS * CONV_P1) / 100)
#define CONV_SPLIT2 ((CONV_TICKETS * CONV_P2) / 100)
#define NCONV 16
#endif

constexpr int LDS_BYTES = 163840;
constexpr int SCR_BYTES = 155648;
constexpr int TAB_OFF = SCR_BYTES;
constexpr int MISC_OFF = SCR_BYTES + 4096;
constexpr int EPF_OFF = 139264;
constexpr int NWAVES = 8;

#define LDS_WAIT() asm volatile("s_waitcnt lgkmcnt(0)" ::: "memory")
#define VM_WAIT() asm volatile("s_waitcnt vmcnt(0)" ::: "memory")
#define SBAR() __builtin_amdgcn_sched_barrier(0)

__device__ __forceinline__ unsigned f2bf(float f) { unsigned u = __builtin_bit_cast(unsigned, f); return (u + 0x7fffu + ((u >> 16) & 1u)) >> 16; }
__device__ __forceinline__ unsigned pk2(float lo, float hi) { unsigned r; asm("v_cvt_pk_bf16_f32 %0, %1, %2" : "=v"(r) : "v"(lo), "v"(hi)); return r; }
__device__ __forceinline__ float bf2f(unsigned b) { return __builtin_bit_cast(float, b << 16); }
__device__ __forceinline__ float bflo(unsigned w) { return __builtin_bit_cast(float, w << 16); }
__device__ __forceinline__ float bfhi(unsigned w) { return __builtin_bit_cast(float, w & 0xffff0000u); }
__device__ __forceinline__ unsigned cvtpk(float lo, float hi) { unsigned r; asm volatile("v_cvt_pk_bf16_f32 %0, %1, %2" : "=v"(r) : "v"(lo), "v"(hi)); return r; }
__device__ __forceinline__ float clamp448(float x) { return fminf(fmaxf(x, -448.f), 448.f); }
__device__ __forceinline__ unsigned pk4_fp8(float a, float b, float c, float d) {
    unsigned w = 0; w = __builtin_amdgcn_cvt_pk_fp8_f32(clamp448(a), clamp448(b), w, false); w = __builtin_amdgcn_cvt_pk_fp8_f32(clamp448(c), clamp448(d), w, true); return w; }
constexpr float FP8_SW = 512.f, FP8_SX = 8.f, FP8_SA = 4.f, FP8_SY = 32.f;
__device__ __forceinline__ int lane_id() { int l = threadIdx.x & 63; asm volatile("" : "+v"(l)); return l; }
__device__ __forceinline__ int crow(int r, int hi) { return (r & 3) + 8 * (r >> 2) + 4 * hi; }
template <int CTRL> __device__ __forceinline__ float dpp_mov(float v) { return __builtin_bit_cast(float, __builtin_amdgcn_update_dpp(0, __builtin_bit_cast(int, v), CTRL, 0xf, 0xf, true)); }
__device__ __forceinline__ float red16(float v) {
    v += dpp_mov<0xB1>(v); v += dpp_mov<0x4E>(v); v += dpp_mov<0x141>(v); v += dpp_mov<0x140>(v); return v; }
__device__ __forceinline__ float red_x16(float v) {
    float a = v, b = v; asm volatile("s_nop 1\n\tv_permlane16_swap_b32 %0, %1\n\ts_nop 1" : "+v"(a), "+v"(b)); return a + b; }
__device__ __forceinline__ float red_x32(float v) {
    float a = v, b = v; asm volatile("s_nop 1\n\tv_permlane32_swap_b32 %0, %1\n\ts_nop 1" : "+v"(a), "+v"(b)); return a + b; }
__device__ __forceinline__ float wave_sum(float v) {
    return red_x32(red_x16(red16(v)));
}

#define XB_TMO      128
#define XB_XCNT(j)  (256  + 64 * (j))
#define XB_XSUB(j)  (1280 + 64 * (j))
#define XB_XGEN(j)  (2304 + 64 * (j))
#define XB_TOP      3328
#define XB_TOPGEN   3392
#define XCD_BAR_WORDS 3456
#define XB_SPIN_CAP (1u << 18)
__device__ __forceinline__ unsigned xb_ld(unsigned* p)              { return __hip_atomic_load(p, __ATOMIC_RELAXED, __HIP_MEMORY_SCOPE_AGENT); }
__device__ __forceinline__ unsigned xb_add(unsigned* p, unsigned v) { return __hip_atomic_fetch_add(p, v, __ATOMIC_RELAXED, __HIP_MEMORY_SCOPE_AGENT); }
__device__ __forceinline__ unsigned xb_xcc_id() { return (unsigned)__builtin_amdgcn_s_getreg((3 << 11) | 20) & 0xFu; }
#define XB_SPIN(cond, bar) do { unsigned _sp = 0; while (cond) { __builtin_amdgcn_s_sleep(1); \
    if ((++_sp & 255u) == 0u) { if (xb_ld(&(bar)[XB_TMO])) break; if (_sp > XB_SPIN_CAP) { atomicAdd(&(bar)[XB_TMO], 1u); break; } } } } while (0)
struct XcdBarrier { unsigned* bar; unsigned x; volatile LAS unsigned* st; };
__device__ __forceinline__ XcdBarrier xcd_barrier_post(unsigned* bar, volatile LAS unsigned* st) {
    XcdBarrier b; b.bar = bar; b.x = xb_xcc_id(); b.st = st;
    if (threadIdx.x == 0) (void)xb_add(&bar[XB_XCNT(b.x)], 1u);
    return b;
}
__device__ __forceinline__ void xcd_barrier_complete(unsigned* bar, unsigned x, unsigned& nloc, unsigned& nx) {
    const unsigned G = gridDim.x * gridDim.y * gridDim.z;
    unsigned sum, cnt, mine, sp = 0u;
    for (;;) {
        sum = 0u; cnt = 0u; mine = 0u;
#pragma unroll
        for (unsigned j = 0; j < 16; ++j) { const unsigned c = xb_ld(&bar[XB_XCNT(j)]); sum += c; cnt += (c > 0u) ? 1u : 0u; mine = (j == x) ? c : mine; }
        if (sum == G) break;
        __builtin_amdgcn_s_sleep(1);
        if ((++sp & 255u) == 0u) { if (xb_ld(&bar[XB_TMO])) break; if (sp > XB_SPIN_CAP) { atomicAdd(&bar[XB_TMO], 1u); break; } }
    }
    nloc = mine > 0u ? mine : 1u; nx = cnt > 0u ? cnt : 1u;
}
__device__ __forceinline__ void xcd_barrier(const XcdBarrier& b) {
    asm volatile("s_waitcnt vmcnt(0)" ::: "memory");
    __syncthreads();
    if (threadIdx.x == 0) {
        unsigned* bar = b.bar;
        __builtin_amdgcn_s_waitcnt(0);
        unsigned nloc = b.st[0], nx = b.st[1];
        if (nloc == 0u) { xcd_barrier_complete(bar, b.x, nloc, nx); b.st[0] = nloc; b.st[1] = nx; }
        const unsigned old = xb_add(&bar[XB_XSUB(b.x)], 1u);
        const unsigned gen = old / nloc;
        if (old + 1u == (gen + 1u) * nloc) {
            __builtin_amdgcn_fence(__ATOMIC_RELEASE, "agent");
            asm volatile("s_waitcnt vmcnt(0)" ::: "memory");
            const unsigned og = xb_add(&bar[XB_TOP], 1u);
            const unsigned tg = og / nx;
            if (og + 1u == (tg + 1u) * nx) xb_add(&bar[XB_TOPGEN], 1u);
            else XB_SPIN(xb_ld(&bar[XB_TOPGEN]) == tg, bar);
            __builtin_amdgcn_fence(__ATOMIC_ACQUIRE, "agent");
            xb_add(&bar[XB_XGEN(b.x)], 1u);
            asm volatile("s_waitcnt vmcnt(0)" ::: "memory");
        } else {
            XB_SPIN(xb_ld(&bar[XB_XGEN(b.x)]) == gen, bar);
            __builtin_amdgcn_fence(__ATOMIC_ACQUIRE, "agent");
            asm volatile("s_waitcnt vmcnt(0)" ::: "memory");
        }
    }
    __syncthreads();
}

#ifndef PG8_SP2
#define PG8_SP2 true
#endif
#ifndef PG8_ALIGN
#define PG8_ALIGN true
#endif
namespace pg8 {
constexpr int BM = 256, BK = 64, HALF = 128, HTB = HALF * BK * 2, STAGE_BYTES = 8 * HTB, NXCD = 8, WGM = 8;
__host__ __device__ __forceinline__ int lds_byte(int r, int c) { return r * 128 + ((((c >> 3)) ^ ((r >> 1) & 7)) << 4) + (c & 7) * 2; }
__host__ __device__ __forceinline__ void stage_rc(int b, int& R, int& C) { R = b >> 7; C = ((((b >> 4) & 7) ^ ((R >> 1) & 7)) << 3) + ((b & 15) >> 1); }
__host__ __device__ __forceinline__ int perm32(int rho) { const int n = rho >> 4, i = rho & 15; return 8 * (i >> 2) + 4 * n + (i & 3); }
struct Unit { int pm, pn, e; };
__device__ __forceinline__ bool order_next(int i, int G, int c, int nM, int nN, int& pm, int& pn) {
    const int nwg = nM * nN; const long L = (long)i * G + c; if (L >= nwg) return false;
    int wgid = (int)L; { const int q = nwg / NXCD, r = nwg % NXCD, xcd = wgid % NXCD, off = wgid / NXCD; wgid = (xcd < r ? xcd * (q + 1) : r * (q + 1) + (xcd - r) * q) + off; }
    const int nig = WGM * nN, gid = wgid / nig, fm = gid * WGM, gsz = (nM - fm) < WGM ? (nM - fm) : WGM;
    pm = fm + ((wgid % nig) % gsz); pn = (wgid % nig) / gsz; return true;
}

typedef int i32x8 __attribute__((ext_vector_type(8)));
__device__ __forceinline__ i32x8 cat16(bf16x8 lo, bf16x8 hi) { const v4u a = __builtin_bit_cast(v4u, lo), b = __builtin_bit_cast(v4u, hi); return (i32x8){(int)a.x, (int)a.y, (int)a.z, (int)a.w, (int)b.x, (int)b.y, (int)b.z, (int)b.w}; }
template <class Epi, class Sched, bool GATHER, bool FP8, bool SP2 = PG8_SP2, bool ALIGN_EPI = PG8_ALIGN>
__device__ __forceinline__ void gemm_phase(LAS unsigned char* lds, const int pitchB, const Sched& S, const Epi& E) {
    const int tid = threadIdx.x, wid = __builtin_amdgcn_readfirstlane(tid >> 6), lane = tid & 63, wr = wid >> 2, wc = wid & 3, fr = lane & 15, fq = lane >> 4;
    const int nt = pitchB / 128;
    const size_t kstep = (size_t)128;
    const size_t hstep = (size_t)HALF * pitchB;
    unsigned voffB[2], voA[4];
#pragma unroll
    for (int i = 0; i < 2; ++i) { int R, C; stage_rc(tid * 16 + i * 8192, R, C); const int Rb = Epi::PERM ? ((R & ~31) + perm32(R & 31)) : R;
        voA[i] = (unsigned)(R * pitchB + C * 2); voA[2 + i] = voA[i] + (unsigned)hstep; voffB[i] = (unsigned)(Rb * pitchB + C * 2); }
    const unsigned ldsw = (unsigned)wid * 1024u;
    const int aoffk[2] = {lds_byte(wr * 64 + fr, fq * 8), lds_byte(wr * 64 + fr, 32 + fq * 8)}, boffk[2] = {lds_byte(wc * 32 + fr, fq * 8), lds_byte(wc * 32 + fr, 32 + fq * 8)};
#define PG8_SA(b, h) (((b) * 2 + (h)) * HTB)
#define PG8_SB(b, h) ((4 + (b) * 2 + (h)) * HTB)
#define PG8_STAGE2(bufoff, gbase, o0, o1) do { \
        __builtin_amdgcn_global_load_lds((const unsigned*)((const char*)(gbase) + (o0)), (LAS unsigned*)(lds + (bufoff) + ldsw), 16, 0, 0); \
        __builtin_amdgcn_global_load_lds((const unsigned*)((const char*)(gbase) + (o1)), (LAS unsigned*)(lds + (bufoff) + ldsw + 8192), 16, 0, 0); } while (0)
#define PG8_STAGEB(bufoff, gbase) PG8_STAGE2(bufoff, gbase, voffB[0], voffB[1])
#ifndef PROBE_LDS2
#define PROBE_LDS2 0
#endif
#ifndef PROBE_EPI
#define PROBE_EPI 0
#endif
#define PG8_LDA1(dst, b, h) do { _Pragma("unroll") for (int m = 0; m < 4; ++m) _Pragma("unroll") for (int k = 0; k < 2; ++k) dst[m][k] = *(const LAS bf16x8*)(lds + PG8_SA(b, h) + aoffk[k] + m * 2048); } while (0)
#define PG8_LDA(dst, b, h) do { if (PROBE_LDS2) { _Pragma("unroll") for (int m = 0; m < 4; ++m) _Pragma("unroll") for (int k = 0; k < 2; ++k) { bf16x8 t_ = *(const LAS bf16x8*)(lds + PG8_SA(b, h) + aoffk[k] + m * 2048); asm volatile("" :: "v"(t_)); } asm volatile("" ::: "memory"); } PG8_LDA1(dst, b, h); } while (0)
#define PG8_LDB1(dst, b, h) do { _Pragma("unroll") for (int n = 0; n < 2; ++n) _Pragma("unroll") for (int k = 0; k < 2; ++k) dst[n][k] = *(const LAS bf16x8*)(lds + PG8_SB(b, h) + boffk[k] + n * 2048); } while (0)
#define PG8_LDB(dst, b, h) do { if (PROBE_LDS2) { _Pragma("unroll") for (int n = 0; n < 2; ++n) _Pragma("unroll") for (int k = 0; k < 2; ++k) { bf16x8 t_ = *(const LAS bf16x8*)(lds + PG8_SB(b, h) + boffk[k] + n * 2048); asm volatile("" :: "v"(t_)); } asm volatile("" ::: "memory"); } PG8_LDB1(dst, b, h); } while (0)
#define PG8_MMA(ai, bj, At, Bt) do { __builtin_amdgcn_s_setprio(1); _Pragma("unroll") for (int m = 0; m < 4; ++m) _Pragma("unroll") for (int n = 0; n < 2; ++n) { \
        if constexpr (FP8) { const i32x8 b8_ = cat16(Bt[n][0], Bt[n][1]), a8_ = cat16(At[m][0], At[m][1]); \
            asm volatile("v_mfma_scale_f32_16x16x128_f8f6f4 %0, %1, %2, %0, %3, %3 op_sel_hi:[0,0,0]" : "+v"(acc[ai][bj][m][n]) : "v"(b8_), "v"(a8_), "v"(one_scale)); } \
        else { _Pragma("unroll") for (int k = 0; k < 2; ++k) acc[ai][bj][m][n] = __builtin_amdgcn_mfma_f32_16x16x32_bf16(Bt[n][k], At[m][k], acc[ai][bj][m][n], 0, 0, 0); } } \
        __builtin_amdgcn_s_setprio(0); } while (0)
#define PG8_WAIT_V(n) asm volatile("s_waitcnt vmcnt(" #n ")" ::: "memory")
#define PG8_WAIT_L(n) asm volatile("s_waitcnt lgkmcnt(" #n ")" ::: "memory")
#define PG8_BAR __builtin_amdgcn_s_barrier()
#define PG8_SCHED __builtin_amdgcn_sched_barrier(0)
    Unit cur, nxt; int ui = 0;
    if (!S.next(0, cur)) return;
    const unsigned one_scale = 0x7F7F7F7Fu;
    f32x4 acc[2][2][4][2];
#pragma unroll
    for (int a = 0; a < 2; ++a)
#pragma unroll
        for (int b = 0; b < 2; ++b)
#pragma unroll
            for (int m = 0; m < 4; ++m)
#pragma unroll
                for (int n = 0; n < 2; ++n) acc[a][b][m][n] = (f32x4){0.f, 0.f, 0.f, 0.f};
    bf16x8 At[4][2], B0[2][2], B1[2][2];
    const char* cA = S.a_base(cur); const char* cB = S.b_base(cur);
    unsigned voN[4];
    if constexpr (GATHER) { S.a_off(cur, tid, voA); }
#pragma unroll
    for (int i = 0; i < 4; ++i) voN[i] = voA[i];
    if constexpr (SP2) {
        PG8_STAGEB(PG8_SB(0, 0), cB); PG8_STAGEB(PG8_SB(0, 1), cB + hstep); PG8_STAGE2(PG8_SA(0, 0), cA, voA[0], voA[1]); PG8_STAGE2(PG8_SA(0, 1), cA, voA[2], voA[3]);
        if (wr == 1) PG8_BAR;
        PG8_WAIT_V(2); PG8_BAR;
        PG8_STAGEB(PG8_SB(1, 0), cB + kstep); PG8_STAGE2(PG8_SA(1, 0), cA + kstep, voA[0], voA[1]); PG8_STAGEB(PG8_SB(1, 1), cB + hstep + kstep);
        PG8_WAIT_V(6); PG8_BAR;
    } else {
        PG8_STAGEB(PG8_SB(0, 0), cB); PG8_STAGE2(PG8_SA(0, 0), cA, voA[0], voA[1]); PG8_STAGEB(PG8_SB(0, 1), cB + hstep); PG8_STAGE2(PG8_SA(0, 1), cA, voA[2], voA[3]);
        if (wr == 1) PG8_BAR;
        PG8_WAIT_V(4); PG8_BAR;
        PG8_STAGEB(PG8_SB(1, 0), cB + kstep); PG8_STAGE2(PG8_SA(1, 0), cA + kstep, voA[0], voA[1]); PG8_STAGEB(PG8_SB(1, 1), cB + hstep + kstep);
        PG8_WAIT_V(6); PG8_BAR;
    }
    for (;;) {
        const bool has_next = S.next(ui + 1, nxt);
        const bool skip1 = S.skip_hi(cur);
        const char* nA = has_next ? S.a_base(nxt) : cA; const char* nB = has_next ? S.b_base(nxt) : cB;
        for (int t = 0; t < nt; t += 2) {
            const bool last = (t == nt - 2);
            const char* a1 = cA + (size_t)(t + 1) * kstep;
            const char* a2 = last ? nA : cA + (size_t)(t + 2) * kstep; const char* b2 = last ? nB : cB + (size_t)(t + 2) * kstep;
            const char* a3 = a2 + kstep; const char* b3 = b2 + kstep;
            unsigned v2[4];
            if constexpr (GATHER) {
                if (t == nt - 4 && has_next) S.a_tok_dma(nxt, lds, wid, lane);
                if (last && has_next) S.a_off_lds(lds, tid, voN);
#pragma unroll
                for (int i = 0; i < 4; ++i) v2[i] = last ? voN[i] : voA[i];
            } else {
#pragma unroll
                for (int i = 0; i < 4; ++i) v2[i] = voA[i];
            }
            if (last) E.prefetch(cur, lds, wid, lane);
            if constexpr (SP2) {
            PG8_LDB(B0, 0, 0); PG8_LDB(B1, 0, 1); PG8_SCHED; PG8_LDA(At, 0, 0); PG8_STAGE2(PG8_SA(1, 1), a1, voA[2], voA[3]);
            PG8_WAIT_V(8); PG8_WAIT_L(0); PG8_BAR; PG8_MMA(0, 0, At, B0); PG8_MMA(0, 1, At, B1); PG8_BAR; PG8_SCHED;
            PG8_LDA(At, 0, 1); PG8_STAGEB(PG8_SB(0, 0), b2); PG8_STAGEB(PG8_SB(0, 1), b2 + hstep); PG8_STAGE2(PG8_SA(0, 0), a2, v2[0], v2[1]);
            PG8_WAIT_V(8); PG8_WAIT_L(0); PG8_BAR; if (!skip1) { PG8_MMA(1, 0, At, B0); PG8_MMA(1, 1, At, B1); } PG8_BAR; PG8_SCHED;
            PG8_LDB(B0, 1, 0); PG8_LDB(B1, 1, 1); PG8_SCHED; PG8_LDA(At, 1, 0); PG8_STAGE2(PG8_SA(0, 1), a2, v2[2], v2[3]);
            PG8_WAIT_V(8); PG8_WAIT_L(0); PG8_BAR; PG8_MMA(0, 0, At, B0); PG8_MMA(0, 1, At, B1); PG8_BAR; PG8_SCHED;
            PG8_LDA(At, 1, 1); PG8_STAGEB(PG8_SB(1, 0), b3); PG8_STAGEB(PG8_SB(1, 1), b3 + hstep); PG8_STAGE2(PG8_SA(1, 0), a3, v2[0], v2[1]);
            PG8_WAIT_V(8); PG8_WAIT_L(0); PG8_BAR; if (!skip1) { PG8_MMA(1, 0, At, B0); PG8_MMA(1, 1, At, B1); } PG8_BAR; PG8_SCHED;
            } else {
            PG8_LDB(B0, 0, 0); PG8_SCHED; PG8_LDA(At, 0, 0); PG8_STAGE2(PG8_SA(1, 1), a1, voA[2], voA[3]);
            PG8_WAIT_L(8); PG8_BAR; PG8_WAIT_L(0); PG8_MMA(0, 0, At, B0); PG8_BAR; PG8_SCHED;
            PG8_LDB(B1, 0, 1); PG8_STAGEB(PG8_SB(0, 0), b2);
            PG8_BAR; PG8_WAIT_L(0); PG8_MMA(0, 1, At, B1); PG8_BAR;
            PG8_LDA(At, 0, 1); PG8_STAGE2(PG8_SA(0, 0), a2, v2[0], v2[1]);
            PG8_BAR; PG8_WAIT_L(0); PG8_MMA(1, 0, At, B0); PG8_BAR; PG8_SCHED;
            PG8_STAGEB(PG8_SB(0, 1), b2 + hstep);
            PG8_WAIT_V(6); PG8_BAR; PG8_MMA(1, 1, At, B1); PG8_BAR;
            PG8_LDB(B0, 1, 0); PG8_SCHED; PG8_LDA(At, 1, 0); PG8_STAGE2(PG8_SA(0, 1), a2, v2[2], v2[3]);
            PG8_WAIT_L(8); PG8_BAR; PG8_WAIT_L(0); PG8_MMA(0, 0, At, B0); PG8_BAR; PG8_SCHED;
            PG8_LDB(B1, 1, 1); PG8_STAGEB(PG8_SB(1, 0), b3);
            PG8_BAR; PG8_WAIT_L(0); PG8_MMA(0, 1, At, B1); PG8_BAR;
            PG8_LDA(At, 1, 1); PG8_STAGE2(PG8_SA(1, 0), a3, v2[0], v2[1]);
            PG8_BAR; PG8_WAIT_L(0); PG8_MMA(1, 0, At, B0); PG8_BAR; PG8_SCHED;
            PG8_STAGEB(PG8_SB(1, 1), b3 + hstep);
            PG8_WAIT_V(6); PG8_BAR; PG8_MMA(1, 1, At, B1); PG8_BAR;
            }
        }
        if constexpr (ALIGN_EPI) { if (wr == 0) PG8_BAR; }
        if constexpr (FP8) asm volatile("s_nop 15\n\ts_nop 15" ::: "memory");
        E(acc, cur, wr, wc, fr, fq);
        if (PROBE_EPI & Epi::ID) { asm volatile("" ::: "memory"); E(acc, cur, wr, wc, fr, fq); }
        if (!has_next) break;
#pragma unroll
        for (int a = 0; a < 2; ++a)
#pragma unroll
            for (int b = 0; b < 2; ++b)
#pragma unroll
                for (int m = 0; m < 4; ++m)
#pragma unroll
                    for (int n = 0; n < 2; ++n) acc[a][b][m][n] = (f32x4){0.f, 0.f, 0.f, 0.f};
        if constexpr (FP8) asm volatile("s_nop 4" ::: "memory");
        cur = nxt; cA = nA; cB = nB; ++ui;
        if constexpr (ALIGN_EPI) { if (wr == 1) PG8_BAR; }
        if constexpr (GATHER) {
#pragma unroll
            for (int i = 0; i < 4; ++i) voA[i] = voN[i];
        }
    }
    PG8_WAIT_V(0);
    if constexpr (!ALIGN_EPI) { if (wr == 0) PG8_BAR; }
    PG8_BAR;
#undef PG8_SA
#undef PG8_SB
#undef PG8_STAGE2
#undef PG8_STAGEB
#undef PG8_LDA
#undef PG8_LDB
#undef PG8_LDA1
#undef PG8_LDB1
#undef PG8_MMA
#undef PG8_WAIT_V
#undef PG8_WAIT_L
#undef PG8_BAR
#undef PG8_SCHED
}
}

struct Frame {
    LAS unsigned char* lds;
    volatile LAS unsigned* MISC;
    gu32* ctl;
    int tid, wave, vcu, G;
    const float* in[22];
    float* out;
    unsigned char* ws;
};
#define IN_X 0
#define IN_META 1
#define IN_ANG 2
#define IN_WIN 3
#define IN_DECF 4
#define IN_DECB 5
#define IN_RETG 6
#define IN_QG 7
#define IN_KG 8
#define IN_LQ1 9
#define IN_LK1 10
#define IN_LQ2 11
#define IN_LK2 12
#define IN_DOG 13
#define IN_WOUT 14
#define IN_FNG 15
#define IN_WR 16
#define IN_BR 17
#define IN_WGU 18
#define IN_BGU 19
#define IN_WD 20
#define IN_BD 21

__device__ __forceinline__ void p0_transpose_item(const float* W, int K, int N, bf16* WT, int row_off, LAS float* scr, int kb, int nb, int lane) {
    const int k0 = 64 * kb, n0 = 32 * nb;
#pragma unroll 8
    for (int i = 0; i < 32; ++i) { const int kk = 2 * i + (lane >> 5); scr[kk * 33 + (lane & 31)] = W[(size_t)(k0 + kk) * N + n0 + (lane & 31)]; }
    LDS_WAIT(); asm volatile("" ::: "memory");
    const int c = lane & 7;
#pragma unroll
    for (int j = 0; j < 4; ++j) { const int n = (lane >> 3) + 8 * j; const LAS float* s = scr + (8 * c) * 33 + n;
        v4u o; o.x = pk2(s[0 * 33], s[1 * 33]); o.y = pk2(s[2 * 33], s[3 * 33]); o.z = pk2(s[4 * 33], s[5 * 33]); o.w = pk2(s[6 * 33], s[7 * 33]);
        *(GAS v4u*)(WT + (size_t)(row_off + n0 + n) * K + k0 + 8 * c) = o; }
    LDS_WAIT(); asm volatile("" ::: "memory");
}
__device__ __forceinline__ void p0_transpose_item_fp8(const float* W, int K, int N, unsigned char* WT, int row_off, LAS unsigned* tl, int kb, int nb, int lane, float sc) {
    const int k0 = 128 * kb, n0 = 64 * nb, n4 = lane & 15, kq = lane >> 4;
    const float* src = W + (size_t)(k0 + 4 * kq) * N + n0 + 4 * n4;
#pragma unroll
    for (int half = 0; half < 2; ++half) {
        f32x4 v[4][4];
#pragma unroll
        for (int g = 0; g < 4; ++g)
#pragma unroll
            for (int e = 0; e < 4; ++e) v[g][e] = __builtin_nontemporal_load((const GAS f32x4*)(src + (size_t)(16 * (4 * half + g) + e) * N));
#pragma unroll
        for (int g = 0; g < 4; ++g)
#pragma unroll
            for (int c = 0; c < 4; ++c) tl[(4 * n4 + c) * 33 + 4 * (4 * half + g) + kq] = pk4_fp8(v[g][0][c] * sc, v[g][1][c] * sc, v[g][2][c] * sc, v[g][3][c] * sc);
    }
    LDS_WAIT(); asm volatile("" ::: "memory");
    const int ch = lane & 7;
#pragma unroll
    for (int j = 0; j < 8; ++j) { const int n = (lane >> 3) + 8 * j; const LAS unsigned* t = tl + n * 33 + 4 * ch;
        v4u o; o.x = t[0]; o.y = t[1]; o.z = t[2]; o.w = t[3];
        __builtin_nontemporal_store(o, (GAS v4u*)(WT + (size_t)(row_off + n0 + n) * K + k0 + 16 * ch)); }
    LDS_WAIT(); asm volatile("" ::: "memory");
}
__device__ __forceinline__ void rms_row_to_bf16(int lane, const float* xrow, const float* gain, bf16* orow) {
    const GAS f32x4* xr = (const GAS f32x4*)xrow + lane;
    const GAS f32x4* gr = (const GAS f32x4*)gain + lane;
    f32x4 v[8]; float s = 0.f;
#pragma unroll
    for (int j = 0; j < 8; ++j) { v[j] = xr[64 * j]; s += (v[j].x * v[j].x + v[j].y * v[j].y) + (v[j].z * v[j].z + v[j].w * v[j].w); }
    const float rstd = 1.f / sqrtf(wave_sum(s) * (1.f / DM) + EPS);
    GAS v2u* o8 = (GAS v2u*)orow + lane;
#pragma unroll
    for (int j = 0; j < 8; ++j) { const f32x4 g = gr[64 * j]; v2u w; w.x = pk2(v[j].x * rstd * g.x, v[j].y * rstd * g.y); w.y = pk2(v[j].z * rstd * g.z, v[j].w * rstd * g.w); o8[64 * j] = w; }
}
__device__ __forceinline__ void p0_prologue(Frame& F) {
    LAS float* scr = (LAS float*)(F.lds + F.wave * 19456);
    const int gw = F.vcu * NWAVES + F.wave, NGW = F.G * NWAVES;
    bf16* WIN_T = (bf16*)(F.ws + WS_WIN); bf16* WOUT_T = (bf16*)(F.ws + WS_WOUT);
    constexpr int I_IN = 32 * (NIN / 32), I_OUT = 32 * (DM / 32);
    for (int it = gw; it < I_IN + I_OUT; it += NGW) {
        int r = it;
        if (r < I_IN) { const int nbk = NIN / 32; p0_transpose_item(F.in[IN_WIN], DM, NIN, WIN_T, 0, scr, r / nbk, r % nbk, lane_id()); continue; } r -= I_IN;
        { const int nbk = DM / 32; p0_transpose_item(F.in[IN_WOUT], DM, DM, WOUT_T, 0, scr, r / nbk, r % nbk, lane_id()); }
    }
    bf16* U = (bf16*)(F.ws + WS_U);
    for (int m = gw; m < T + NMETA; m += NGW) {
        if (m < T) rms_row_to_bf16(lane_id(), F.in[IN_X] + (size_t)m * DM, F.in[IN_ANG], U + (size_t)m * DM);
        else rms_row_to_bf16(lane_id(), F.in[IN_META] + (size_t)(m - T) * DM, F.in[IN_ANG], U + (size_t)m * DM);
    }
    { bf16* Z = (bf16*)(F.ws + WS_Z);
      for (int m = T + NMETA + gw; m < T + 128; m += NGW) { GAS v4u* o = (GAS v4u*)(Z + (size_t)m * NIN) + lane_id();
#pragma unroll
          for (int j = 0; j < 12; ++j) o[64 * j] = (v4u){0u, 0u, 0u, 0u}; } }
}
__device__ __forceinline__ void p0_expert_item(Frame& F, int it) {
    LAS float* scr = (LAS float*)(F.lds + F.wave * 19456);
#if MOE_FP8
    constexpr int KB_E = 16;
    unsigned char* WGU_T = F.ws + WS_WGU; unsigned char* WD_T = F.ws + WS_WD;
#else
    constexpr int KB_E = 32;
    bf16* WGU_T = (bf16*)(F.ws + WS_WGU); bf16* WD_T = (bf16*)(F.ws + WS_WD);
#endif
    constexpr int NBW = MOE_FP8 ? 64 : 32;
    constexpr int I_GU = KB_E * (4096 / NBW), I_D = KB_E * (DM / NBW);
    constexpr int NITEMS = NE * I_GU + NE * I_D;
        int r = it;
        if (r < NE * I_GU) { const int e = r / I_GU, q = r % I_GU, nbk = 4096 / NBW, kb = q / nbk, nb = q % nbk, n0 = NBW * nb;
            const int j = n0 & 2047, isup = n0 >> 11, dest = (j >> 7) * 256 + isup * 128 + (j & 127);
#if MOE_FP8
            p0_transpose_item_fp8(F.in[IN_WGU] + (size_t)e * DM * 4096, DM, 4096, WGU_T + (size_t)e * 4096 * DM, dest - n0, (LAS unsigned*)scr, kb, nb, lane_id(), FP8_SW); return; } r -= NE * I_GU;
#else
            p0_transpose_item(F.in[IN_WGU] + (size_t)e * DM * 4096, DM, 4096, WGU_T + (size_t)e * 4096 * DM, dest - n0, scr, kb, nb, lane_id()); return; } r -= NE * I_GU;
#endif
        { const int e = r / I_D, q = r % I_D, nbk = DM / NBW;
#if MOE_FP8
            p0_transpose_item_fp8(F.in[IN_WD] + (size_t)e * DFF * DM, DFF, DM, WD_T + (size_t)e * DM * DFF, 0, (LAS unsigned*)scr, q / nbk, q % nbk, lane_id(), FP8_SW); }
#else
            p0_transpose_item(F.in[IN_WD] + (size_t)e * DFF * DM, DFF, DM, WD_T + (size_t)e * DM * DFF, 0, scr, q / nbk, q % nbk, lane_id()); }
#endif

}
constexpr int CONV_ITEMS = NE * ((MOE_FP8 ? 16 : 32) * (4096 / (MOE_FP8 ? 64 : 32))) + NE * ((MOE_FP8 ? 16 : 32) * (DM / (MOE_FP8 ? 64 : 32))), CONV_TICKETS = CONV_ITEMS / NWAVES;
__device__ __forceinline__ void p0_experts_q(Frame& F, int cw, int first, int last) {
    for (;;) {
        __syncthreads();
        if (F.tid == 0) F.MISC[22] = __hip_atomic_fetch_add(F.ctl + cw, 1u, __ATOMIC_RELAXED, __HIP_MEMORY_SCOPE_AGENT);
        __syncthreads();
        const int t = first + __builtin_amdgcn_readfirstlane((int)F.MISC[22]);
        if (t >= last) break;
        p0_expert_item(F, t * NWAVES + F.wave);
    }
    __syncthreads();
}
__device__ __forceinline__ void p1_meta_rows(Frame& F) {
    int lane = lane_id(); asm volatile("" : "+v"(lane));
    const int gw = F.vcu * NWAVES + F.wave;
    if (gw >= 224) return;
    const bf16* U = (const bf16*)(F.ws + WS_U); const bf16* W = (const bf16*)(F.ws + WS_WIN); bf16* Z = (bf16*)(F.ws + WS_Z);
    const int col0 = gw < 32 ? C_RK + 16 * gw : gw < 96 ? C_RV + 16 * (gw - 32) : C_DK + 16 * (gw - 96);
    const bf16* ap = U + (size_t)(T + (lane & 15)) * DM + 8 * (lane >> 4);
    const bf16* bp = W + (size_t)(col0 + (lane & 15)) * DM + 8 * (lane >> 4);
    f32x4 acc = (f32x4){0.f, 0.f, 0.f, 0.f};
#pragma unroll 8
    for (int st = 0; st < DM / 32; ++st) { const bf16x8 a = *(const GAS bf16x8*)(ap + 32 * st), b = *(const GAS bf16x8*)(bp + 32 * st);
        acc = __builtin_amdgcn_mfma_f32_16x16x32_bf16(a, b, acc, 0, 0, 0); }
    const float sc = gw < 32 ? 0.08838834764831845f : 1.f;
#pragma unroll
    for (int r = 0; r < 4; ++r) Z[(size_t)(T + 4 * (lane >> 4) + r) * NIN + col0 + (lane & 15)] = (bf16)f2bf(acc[r] * sc);
}

struct DenseSched {
    const bf16* A; const bf16* Bt; int nM, nN, pitch, G, c;
    __device__ __forceinline__ bool next(int i, pg8::Unit& u) const { u.e = 0; return pg8::order_next(i, G, c, nM, nN, u.pm, u.pn); }
    __device__ __forceinline__ const char* a_base(const pg8::Unit& u) const { return (const char*)A + (size_t)u.pm * 256 * pitch; }
    __device__ __forceinline__ const char* b_base(const pg8::Unit& u) const { return (const char*)Bt + (size_t)u.pn * 256 * pitch; }
    __device__ __forceinline__ void a_off(const pg8::Unit&, int, unsigned (&)[4]) const {}
    __device__ __forceinline__ bool skip_hi(const pg8::Unit&) const { return false; }
    __device__ __forceinline__ void a_tok_dma(const pg8::Unit&, LAS unsigned char*, int, int) const {}
    __device__ __forceinline__ void a_off_lds(LAS unsigned char*, int, unsigned (&)[4]) const {}
};
struct QueueSched {
    const bf16* A; const bf16* Bt; int nQ, nN, pitch, q0; gu32* cnt; volatile LAS int* slot;
    __device__ __forceinline__ bool next(int i, pg8::Unit& u) const {
        const int per_q = 8 * nN;
        if (threadIdx.x == 0) { int L = -1;
            for (int k = 0; k < nQ; ++k) { const int q = (q0 + k) % nQ; const unsigned t = __hip_atomic_fetch_add(cnt + 64 * q, 1u, __ATOMIC_RELAXED, __HIP_MEMORY_SCOPE_AGENT);
                if (t < (unsigned)per_q) { L = q * per_q + (int)t; break; } }
            slot[i & 1] = L; }
        asm volatile("s_waitcnt lgkmcnt(0)" ::: "memory"); __builtin_amdgcn_s_barrier(); asm volatile("" ::: "memory");
        const int L = __builtin_amdgcn_readfirstlane(slot[i & 1]);
        if (L < 0) return false;
        const int q = L / per_q, t = L % per_q; u.pm = 8 * q + (t & 7); u.pn = t >> 3; u.e = 0; return true; }
    __device__ __forceinline__ const char* a_base(const pg8::Unit& u) const { return (const char*)A + (size_t)u.pm * 256 * pitch; }
    __device__ __forceinline__ const char* b_base(const pg8::Unit& u) const { return (const char*)Bt + (size_t)u.pn * 256 * pitch; }
    __device__ __forceinline__ void a_off(const pg8::Unit&, int, unsigned (&)[4]) const {}
    __device__ __forceinline__ bool skip_hi(const pg8::Unit&) const { return false; }
    __device__ __forceinline__ void a_tok_dma(const pg8::Unit&, LAS unsigned char*, int, int) const {}
    __device__ __forceinline__ void a_off_lds(LAS unsigned char*, int, unsigned (&)[4]) const {}
};
struct EpiZ {
    static constexpr bool PERM = true; static constexpr int ID = 1;
    bf16* Z; const float* qg; const float* kg; LAS float* P;
    __device__ __forceinline__ void prefetch(const pg8::Unit&, LAS unsigned char*, int, int) const {}
    __device__ __forceinline__ void operator()(const f32x4 (&acc)[2][2][4][2], const pg8::Unit& u, int wr, int wc, int fr, int fq) const {
        const int row0 = u.pm * 256 + wr * 64 + fr, col0 = u.pn * 256 + wc * 32 + 8 * fq;
        if (u.pn >= 12 && u.pn < 20) {
            const float* gp = (u.pn < 16 ? qg : kg) + wc * 32 + 8 * fq; const float gs = u.pn < 16 ? 0.08838834764831845f : 1.f;
            const f32x4 g0 = *(const f32x4*)gp * gs, g1 = *(const f32x4*)(gp + 4) * gs;
#pragma unroll
            for (int ai = 0; ai < 2; ++ai)
#pragma unroll
                for (int m = 0; m < 4; ++m)
#pragma unroll
                    for (int bj = 0; bj < 2; ++bj) { const f32x4 a = acc[ai][bj][m][0], b = acc[ai][bj][m][1];
                        float sq = (a[0] * a[0] + a[1] * a[1]) + (a[2] * a[2] + a[3] * a[3]) + (b[0] * b[0] + b[1] * b[1]) + (b[2] * b[2] + b[3] * b[3]);
                        sq = red_x32(red_x16(sq));
                        if (fq == 0) P[(ai * 128 + wr * 64 + m * 16 + fr) * 8 + bj * 4 + wc] = sq; }
            asm volatile("s_waitcnt lgkmcnt(0)" ::: "memory"); __builtin_amdgcn_s_barrier(); asm volatile("" ::: "memory");
#pragma unroll
            for (int ai = 0; ai < 2; ++ai)
#pragma unroll
                for (int m = 0; m < 4; ++m) { bf16* rowp = Z + (size_t)(row0 + ai * 128 + m * 16) * NIN + col0;
#pragma unroll
                    for (int bj = 0; bj < 2; ++bj) { const f32x4 pp = *(const LAS f32x4*)(P + (ai * 128 + wr * 64 + m * 16 + fr) * 8 + bj * 4);
                        const float rstd = __builtin_amdgcn_rsqf(((pp[0] + pp[1]) + (pp[2] + pp[3])) * (1.f / 128.f) + EPS);
                        const f32x4 v0 = acc[ai][bj][m][0] * g0 * rstd, v1 = acc[ai][bj][m][1] * g1 * rstd;
                        v4u w; w.x = cvtpk(v0[0], v0[1]); w.y = cvtpk(v0[2], v0[3]); w.z = cvtpk(v1[0], v1[1]); w.w = cvtpk(v1[2], v1[3]);
                        *(v4u*)(rowp + bj * 128) = w; } }
            return;
        }
        const float s = (u.pn == 2 || u.pn == 3) ? 0.08838834764831845f : 1.f;
#pragma unroll
        for (int ai = 0; ai < 2; ++ai)
#pragma unroll
            for (int m = 0; m < 4; ++m) { bf16* rowp = Z + (size_t)(row0 + ai * 128 + m * 16) * NIN + col0;
#pragma unroll
                for (int bj = 0; bj < 2; ++bj) { const f32x4 v0 = acc[ai][bj][m][0] * s, v1 = acc[ai][bj][m][1] * s;
                    v4u w; w.x = cvtpk(v0[0], v0[1]); w.y = cvtpk(v0[2], v0[3]); w.z = cvtpk(v1[0], v1[1]); w.w = cvtpk(v1[2], v1[3]);
                    *(v4u*)(rowp + bj * 128) = w; } }
    }
};
struct EpiOut {
    static constexpr bool PERM = true; static constexpr int ID = 2;
    const float* X; bf16* H;
    __device__ __forceinline__ void prefetch(const pg8::Unit&, LAS unsigned char*, int, int) const {}
    __device__ __forceinline__ void operator()(const f32x4 (&acc)[2][2][4][2], const pg8::Unit& u, int wr, int wc, int fr, int fq) const {
        const int row0 = u.pm * 256 + wr * 64 + fr, col0 = u.pn * 256 + wc * 32 + 8 * fq;
#pragma unroll
        for (int ai = 0; ai < 2; ++ai) {
            f32x4 xv[4][2][2];
#pragma unroll
            for (int m = 0; m < 4; ++m) { const size_t off = (size_t)(row0 + ai * 128 + m * 16) * DM + col0;
#pragma unroll
                for (int bj = 0; bj < 2; ++bj)
#pragma unroll
                    for (int n = 0; n < 2; ++n) xv[m][bj][n] = *(const f32x4*)(X + off + bj * 128 + n * 4); }
            asm volatile("" ::: "memory");
#pragma unroll
            for (int m = 0; m < 4; ++m) { const size_t off = (size_t)(row0 + ai * 128 + m * 16) * DM + col0;
#pragma unroll
                for (int bj = 0; bj < 2; ++bj) { const f32x4 v0 = acc[ai][bj][m][0] + xv[m][bj][0], v1 = acc[ai][bj][m][1] + xv[m][bj][1];
                    v4u w; w.x = cvtpk(v0[0], v0[1]); w.y = cvtpk(v0[2], v0[3]); w.z = cvtpk(v1[0], v1[1]); w.w = cvtpk(v1[2], v1[3]);
                    *(v4u*)(H + off + bj * 128) = w; } }
            asm volatile("" ::: "memory"); }
    }
};
struct MoeTab { LAS int* cnt; LAS int* rbase; LAS int* tile_e; LAS int* tile_r0; LAS int* ntiles; };
__device__ __forceinline__ MoeTab moe_tab(Frame& F) {
    MoeTab t; LAS int* p = (LAS int*)(F.lds + TAB_OFF);
    t.cnt = p; t.rbase = p + 32; t.ntiles = p + 64; t.tile_e = p + 128; t.tile_r0 = p + 128 + 320; return t;
}
__device__ __forceinline__ void moe_build_tables(Frame& F) {
    MoeTab t = moe_tab(F);
    __syncthreads();
    if (F.tid < NE) { int c = (int)__hip_atomic_load(F.ctl + CW_CNT + 64 * F.tid, __ATOMIC_RELAXED, __HIP_MEMORY_SCOPE_AGENT); if (c > ECAP) c = ECAP; if (c < 0) c = 0; t.cnt[F.tid] = c; }
    __syncthreads();
    if (F.tid == 0) {
        int nt = 0;
        for (int e = 0; e < NE; ++e) { const int c = t.cnt[e], k = (c + 255) >> 8; t.rbase[e] = nt * 256;
            for (int j = 0; j < k; ++j) { t.tile_e[nt + j] = e; t.tile_r0[nt + j] = j * 256; }
            nt += k; }
        t.ntiles[0] = nt;
    }
    __syncthreads();
}
struct MoeSched {
    const unsigned char* A; const unsigned char* Wt; size_t wstride_bytes; int nN, pitch, G, c; MoeTab tb; const int* tok;
    __device__ __forceinline__ bool next(int i, pg8::Unit& u) const {
        const int nM = tb.ntiles[0]; int pm, pn; if (!pg8::order_next(i, G, c, nM, nN, pm, pn)) return false;
        u.pm = pm; u.pn = pn; u.e = __builtin_amdgcn_readfirstlane(tb.tile_e[pm]); return true; }
    __device__ __forceinline__ const char* a_base(const pg8::Unit& u) const { return tok ? (const char*)A : (const char*)A + (size_t)u.pm * 256 * pitch; }
    __device__ __forceinline__ const char* b_base(const pg8::Unit& u) const { return (const char*)Wt + (size_t)u.e * wstride_bytes + (size_t)u.pn * 256 * pitch; }
    __device__ __forceinline__ bool skip_hi(const pg8::Unit& u) const { return __builtin_amdgcn_readfirstlane(tb.cnt[u.e] - tb.tile_r0[u.pm]) <= 128; }
    __device__ __forceinline__ void a_tok(const pg8::Unit& u, int tid, int (&tk)[4]) const {
        const int r0 = tb.tile_r0[u.pm], cn = tb.cnt[u.e];
#pragma unroll
        for (int i = 0; i < 2; ++i) { int R, C; pg8::stage_rc(tid * 16 + i * 8192, R, C);
#pragma unroll
            for (int h = 0; h < 2; ++h) { const int rl = r0 + h * 128 + R; tk[2 * h + i] = tok[(size_t)u.e * ECAP + (rl < cn ? rl : 0)] * (rl < cn ? 1 : 0); } }
    }
    __device__ __forceinline__ void a_off_tok(const int (&tk)[4], int tid, unsigned (&vo)[4]) const {
#pragma unroll
        for (int i = 0; i < 2; ++i) { int R, C; pg8::stage_rc(tid * 16 + i * 8192, R, C);
#pragma unroll
            for (int h = 0; h < 2; ++h) vo[2 * h + i] = (unsigned)tk[2 * h + i] * (unsigned)pitch + (unsigned)C * 2u; }
    }
    __device__ __forceinline__ void a_off(const pg8::Unit& u, int tid, unsigned (&vo)[4]) const { int tk[4]; a_tok(u, tid, tk); a_off_tok(tk, tid, vo); }
    __device__ __forceinline__ void a_tok_dma(const pg8::Unit& u, LAS unsigned char* lds, int wid, int lane) const {
        if (wid < 4) { const int rl = tb.tile_r0[u.pm] + wid * 64 + lane;
            __builtin_amdgcn_global_load_lds((const unsigned*)(tok + (size_t)u.e * ECAP + (rl < tb.cnt[u.e] ? rl : 0)), (LAS unsigned*)(lds + EPF_OFF + 2048) + wid * 64, 4, 0, 0); }
    }
    __device__ __forceinline__ void a_off_lds(LAS unsigned char* lds, int tid, unsigned (&vo)[4]) const {
        const LAS int* TK = (const LAS int*)(lds + EPF_OFF + 2048);
#pragma unroll
        for (int i = 0; i < 2; ++i) { int R, C; pg8::stage_rc(tid * 16 + i * 8192, R, C);
#pragma unroll
            for (int h = 0; h < 2; ++h) vo[2 * h + i] = (unsigned)TK[h * 128 + R] * (unsigned)pitch + (unsigned)C * 2u; }
    }
};
struct EpiAct {
    static constexpr bool PERM = true; static constexpr int ID = 4;
    unsigned char* ACT; const float* bgu; const float* rs; MoeTab tb; LAS unsigned char* lds;
    __device__ __forceinline__ void prefetch(const pg8::Unit& u, LAS unsigned char* lds, int wid, int lane) const {
        LAS unsigned* P = (LAS unsigned*)(lds + EPF_OFF) + wid * 64;
        const float* src;
        if (wid < 4) { const int rl = tb.tile_r0[u.pm] + wid * 64 + lane; src = rs + (size_t)u.e * ECAP + (rl < tb.cnt[u.e] ? rl : 0); }
        else { const int idx = (wid - 4) * 64 + lane; src = bgu + (size_t)u.e * 4096 + u.pn * 128 + (idx & 127) + (idx >> 7) * 2048; }
        __builtin_amdgcn_global_load_lds((const unsigned*)src, P, 4, 0, 0);
    }
    __device__ __forceinline__ void operator()(const f32x4 (&acc)[2][2][4][2], const pg8::Unit& u, int wr, int wc, int fr, int fq) const {
        const int lrow0 = wr * 64 + fr, col0 = u.pn * 128 + wc * 32 + 8 * fq;
        const int r0 = tb.tile_r0[u.pm], cn = tb.cnt[u.e];
        const LAS float* PF = (const LAS float*)(lds + EPF_OFF);
        const LAS float* bg = PF + 256 + wc * 32 + 8 * fq;
        const f32x4 g0 = *(const LAS f32x4*)bg, g1 = *(const LAS f32x4*)(bg + 4), u0 = *(const LAS f32x4*)(bg + 128), u1 = *(const LAS f32x4*)(bg + 132);
        float sv[2][4];
#pragma unroll
        for (int ai = 0; ai < 2; ++ai)
#pragma unroll
            for (int m = 0; m < 4; ++m) { const int rl = r0 + lrow0 + ai * 128 + m * 16; sv[ai][m] = PF[lrow0 + ai * 128 + m * 16] * (rl < cn ? 1.f : 0.f); }
        constexpr float us = MOE_FP8 ? 1.f / (FP8_SX * FP8_SW) : 1.f;
        constexpr float CG = -1.702f * 1.4426950408889634f, SA = MOE_FP8 ? FP8_SA : 1.f, KI = CG / SA;
        const f32x4 g0c = g0 * CG, g1c = g1 * CG, u0p = u0 + 1.f, u1p = u1 + 1.f;
#pragma unroll
        for (int ai = 0; ai < 2; ++ai)
#pragma unroll
            for (int m = 0; m < 4; ++m) { const int lr = lrow0 + ai * 128 + m * 16;
                const float s = sv[ai][m] * us, sc = s * CG;
                f32x4 o4[2];
#pragma unroll
                for (int n = 0; n < 2; ++n) { f32x4 t = acc[ai][0][m][n] * sc + (n ? g1c : g0c), up = acc[ai][1][m][n] * s + (n ? u1p : u0p), r;
#pragma unroll
                    for (int j = 0; j < 4; ++j) { t[j] = fmaxf(t[j], 7.f * CG); up[j] = __builtin_amdgcn_fmed3f(up[j], -6.f, 8.f);
                        r[j] = __builtin_amdgcn_rcpf(__builtin_fmaf(__builtin_amdgcn_exp2f(t[j]), KI, KI)); }
                    o4[n] = up * t * r; }
#if MOE_FP8
                unsigned w0 = 0, w1 = 0;
                w0 = __builtin_amdgcn_cvt_pk_fp8_f32(o4[0][0], o4[0][1], w0, false); w0 = __builtin_amdgcn_cvt_pk_fp8_f32(o4[0][2], o4[0][3], w0, true);
                w1 = __builtin_amdgcn_cvt_pk_fp8_f32(o4[1][0], o4[1][1], w1, false); w1 = __builtin_amdgcn_cvt_pk_fp8_f32(o4[1][2], o4[1][3], w1, true);
                v2u w; w.x = w0; w.y = w1;
                *(v2u*)(ACT + (size_t)(u.pm * 256 + lr) * DFF + col0) = w; }
#else
                v4u w; w.x = cvtpk(o4[0][0], o4[0][1]); w.y = cvtpk(o4[0][2], o4[0][3]); w.z = cvtpk(o4[1][0], o4[1][1]); w.w = cvtpk(o4[1][2], o4[1][3]);
                *(v4u*)(ACT + ((size_t)(u.pm * 256 + lr) * DFF + col0) * 2) = w; }
#endif
    }
};
struct EpiY {
    static constexpr bool PERM = true; static constexpr int ID = 8;
    unsigned char* Y; const float* bd; const float* gate; MoeTab tb; LAS unsigned char* lds;
    __device__ __forceinline__ void prefetch(const pg8::Unit& u, LAS unsigned char* lds, int wid, int lane) const {
        LAS unsigned* P = (LAS unsigned*)(lds + EPF_OFF) + wid * 64;
        const float* src;
        if (wid < 4) { const int rl = tb.tile_r0[u.pm] + wid * 64 + lane; src = gate + (size_t)u.e * ECAP + (rl < tb.cnt[u.e] ? rl : 0); }
        else src = bd + (size_t)u.e * DM + u.pn * 256 + (wid - 4) * 64 + lane;
        __builtin_amdgcn_global_load_lds((const unsigned*)src, P, 4, 0, 0);
    }
    __device__ __forceinline__ void operator()(const f32x4 (&acc)[2][2][4][2], const pg8::Unit& u, int wr, int wc, int fr, int fq) const {
        const int lrow0 = wr * 64 + fr, col0 = u.pn * 256 + wc * 32 + 8 * fq;
        const int r0 = tb.tile_r0[u.pm], cn = tb.cnt[u.e];
        const LAS float* PF = (const LAS float*)(lds + EPF_OFF);
        const LAS float* bp = PF + 256 + wc * 32 + 8 * fq;
        f32x4 bv[2][2];
#pragma unroll
        for (int bj = 0; bj < 2; ++bj) { bv[bj][0] = *(const LAS f32x4*)(bp + bj * 128); bv[bj][1] = *(const LAS f32x4*)(bp + bj * 128 + 4); }
        float gv[2][4];
#pragma unroll
        for (int ai = 0; ai < 2; ++ai)
#pragma unroll
            for (int m = 0; m < 4; ++m) { const int rl = r0 + lrow0 + ai * 128 + m * 16; gv[ai][m] = PF[lrow0 + ai * 128 + m * 16] * (rl < cn ? 1.f : 0.f); }
#pragma unroll
        for (int ai = 0; ai < 2; ++ai)
#pragma unroll
            for (int m = 0; m < 4; ++m) { const int lr = lrow0 + ai * 128 + m * 16;
                const float g = gv[ai][m];
                const size_t ro = (size_t)(u.pm * 256 + lr) * DM + col0;
#pragma unroll
                for (int bj = 0; bj < 2; ++bj) { constexpr float us = MOE_FP8 ? 1.f / (FP8_SA * FP8_SW) : 1.f;
#if Y_FP8
                    const float gs = g * FP8_SY; const f32x4 v0 = (acc[ai][bj][m][0] * us + bv[bj][0]) * gs, v1 = (acc[ai][bj][m][1] * us + bv[bj][1]) * gs;
                    v2u w; w.x = pk4_fp8(v0[0], v0[1], v0[2], v0[3]); w.y = pk4_fp8(v1[0], v1[1], v1[2], v1[3]);
                    *(v2u*)(Y + ro + bj * 128) = w; } }
#else
                    const f32x4 v0 = (acc[ai][bj][m][0] * us + bv[bj][0]) * g, v1 = (acc[ai][bj][m][1] * us + bv[bj][1]) * g;
                    v4u w; w.x = cvtpk(v0[0], v0[1]); w.y = cvtpk(v0[2], v0[3]); w.z = cvtpk(v1[0], v1[1]); w.w = cvtpk(v1[2], v1[3]);
                    *(v4u*)(Y + (ro + bj * 128) * 2) = w; } }
#endif
    }
};

template <int MI, int NI>
__device__ __forceinline__ void lds_mma(f32x16 (&acc)[MI][NI], const LAS bf16* A, int lda, const LAS bf16* B, int ldb, int K, int lane) {
    const int r = lane & 31, h = lane >> 5;
#pragma unroll 2
    for (int k0 = 0; k0 < K; k0 += 16) {
        bf16x8 a[MI], b[NI];
#pragma unroll
        for (int mi = 0; mi < MI; ++mi) a[mi] = *(const LAS bf16x8*)(A + (32 * mi + r) * lda + k0 + 8 * h);
#pragma unroll
        for (int ni = 0; ni < NI; ++ni) b[ni] = *(const LAS bf16x8*)(B + (32 * ni + r) * ldb + k0 + 8 * h);
#pragma unroll
        for (int mi = 0; mi < MI; ++mi)
#pragma unroll
            for (int ni = 0; ni < NI; ++ni) acc[mi][ni] = __builtin_amdgcn_mfma_f32_32x32x16_bf16(a[mi], b[ni], acc[mi][ni], 0, 0, 0);
    }
}
constexpr int LDP = 136;
constexpr int LDO_T = 260;

__device__ __forceinline__ float log2_gamma(float p) { return log2f(1.f - exp2f(-p)); }

__device__ __forceinline__ void p2_fixup(Frame& F) {
    bf16* Z = (bf16*)(F.ws + WS_Z);
    int lane = lane_id(); asm volatile("" : "+v"(lane));
    const int gw = F.vcu * NWAVES + F.wave, NGW = F.G * NWAVES;
    float gq[8], gk[8];
#pragma unroll
    for (int e = 0; e < 8; ++e) { const int d = (8 * lane + e) & 127; gq[e] = F.in[IN_QG][d] * 0.08838834764831845f; gk[e] = F.in[IN_KG][d]; }
    for (int m = T + gw; m < T + NMETA; m += NGW) {
        GAS v4u* p = (GAS v4u*)(Z + (size_t)m * NIN + C_DQ) + lane;
        v4u w[4];
#pragma unroll
        for (int j = 0; j < 4; ++j) w[j] = p[64 * j];
#pragma unroll
        for (int j = 0; j < 4; ++j) {
            float v[8]; v[0] = bflo(w[j].x); v[1] = bfhi(w[j].x); v[2] = bflo(w[j].y); v[3] = bfhi(w[j].y); v[4] = bflo(w[j].z); v[5] = bfhi(w[j].z); v[6] = bflo(w[j].w); v[7] = bfhi(w[j].w);
            float s = 0.f;
#pragma unroll
            for (int e = 0; e < 8; ++e) s += v[e] * v[e];
            s = red16(s);
            const float rstd = 1.f / sqrtf(s * (1.f / 128.f) + EPS);
            v4u o;
            if (j < 2) { o.x = pk2(v[0] * rstd * gq[0], v[1] * rstd * gq[1]); o.y = pk2(v[2] * rstd * gq[2], v[3] * rstd * gq[3]); o.z = pk2(v[4] * rstd * gq[4], v[5] * rstd * gq[5]); o.w = pk2(v[6] * rstd * gq[6], v[7] * rstd * gq[7]); }
            else       { o.x = pk2(v[0] * rstd * gk[0], v[1] * rstd * gk[1]); o.y = pk2(v[2] * rstd * gk[2], v[3] * rstd * gk[3]); o.z = pk2(v[4] * rstd * gk[4], v[5] * rstd * gk[5]); o.w = pk2(v[6] * rstd * gk[6], v[7] * rstd * gk[7]); }
            p[64 * j] = o;
        }
    }
}
template <int NC>
__device__ __forceinline__ void stage_transposed(LAS bf16* dst, const bf16* src, int tid) {
    const int j = tid >> 2, part = tid & 3; constexpr int PER = NC / 4;
    const bf16* s = src + (size_t)j * NIN + part * PER;
#pragma unroll
    for (int q = 0; q < PER / 8; ++q) { const v4u w = *(const GAS v4u*)(s + 8 * q); const int c0 = part * PER + 8 * q;
        dst[(c0 + 0) * LDP + j] = (bf16)(w.x & 0xffffu); dst[(c0 + 1) * LDP + j] = (bf16)(w.x >> 16);
        dst[(c0 + 2) * LDP + j] = (bf16)(w.y & 0xffffu); dst[(c0 + 3) * LDP + j] = (bf16)(w.y >> 16);
        dst[(c0 + 4) * LDP + j] = (bf16)(w.z & 0xffffu); dst[(c0 + 5) * LDP + j] = (bf16)(w.z >> 16);
        dst[(c0 + 6) * LDP + j] = (bf16)(w.w & 0xffffu); dst[(c0 + 7) * LDP + j] = (bf16)(w.w >> 16); }
}
__device__ __forceinline__ void p2_kvstates(Frame& F) {
    const bf16* Z = (const bf16*)(F.ws + WS_Z);
    bf16* KVS = (bf16*)(F.ws + WS_KVS); bf16* META = (bf16*)(F.ws + WS_META);
    LAS bf16* Vt = (LAS bf16*)F.lds;
    LAS bf16* Kt = (LAS bf16*)(F.lds + 256 * LDP * 2);
    for (int u = F.vcu; u < 16 * 32 + 4; u += F.G) {
        int tid = F.tid, wid = F.wave; asm volatile("" : "+v"(tid)); asm volatile("" : "+s"(wid));
        const int lane = tid & 63, we = wid >> 1, wd = wid & 1;
        const bool meta = u >= 512;
        const int bh = meta ? 0 : u >> 5, c = meta ? 0 : u & 31, b = bh >> 2, h = meta ? (u - 512) : (bh & 3);
        const size_t row0 = meta ? (size_t)T : (size_t)b * SEQ + 128 * c;
        const float lgf = log2_gamma(F.in[IN_DECF][h]), lgb = log2_gamma(F.in[IN_DECB][h]);
        __syncthreads();
        stage_transposed<256>(Vt, Z + row0 * NIN + C_RV + 256 * h, tid);
        const int j = tid >> 2, part = tid & 3;
        v4u kw[4];
#pragma unroll
        for (int q = 0; q < 4; ++q) kw[q] = *(const GAS v4u*)(Z + (row0 + j) * NIN + C_RK + 128 * h + 32 * part + 8 * q);
        for (int dir = 0; dir < (meta ? 1 : 2); ++dir) {
            float dec;
            if (meta) dec = (j < NMETA) ? exp2f(lgf * (float)(NMETA - 1 - j)) : 0.f;
            else dec = dir == 0 ? exp2f(lgf * (float)(127 - j)) : exp2f(lgb * (float)j);
            if (dir == 1) __syncthreads();
#pragma unroll
            for (int q = 0; q < 4; ++q) { const int d0 = 32 * part + 8 * q; const unsigned ww[4] = {kw[q].x, kw[q].y, kw[q].z, kw[q].w};
#pragma unroll
                for (int e = 0; e < 4; ++e) { Kt[(d0 + 2 * e) * LDP + j] = (bf16)f2bf(bflo(ww[e]) * dec); Kt[(d0 + 2 * e + 1) * LDP + j] = (bf16)f2bf(bfhi(ww[e]) * dec); } }
            __syncthreads();
            f32x16 acc[2][2];
#pragma unroll
            for (int a = 0; a < 2; ++a)
#pragma unroll
                for (int bb = 0; bb < 2; ++bb) acc[a][bb] = (f32x16){};
            lds_mma<2, 2>(acc, Vt + (64 * we) * LDP, LDP, Kt + (64 * wd) * LDP, LDP, 128, lane);
            bf16* dst = meta ? META + (size_t)h * 32768 : KVS + ((size_t)(bh * 2 + dir) * 32 + c) * 32768;
#pragma unroll
            for (int mi = 0; mi < 2; ++mi)
#pragma unroll
                for (int ni = 0; ni < 2; ++ni)
#pragma unroll
                    for (int r = 0; r < 16; ++r) dst[(64 * we + 32 * mi + crow(r, lane >> 5)) * 128 + 64 * wd + 32 * ni + (lane & 31)] = (bf16)f2bf(acc[mi][ni][r]);
        }
    }
    __syncthreads();
}

__device__ __forceinline__ void p3_scan(Frame& F) {
    bf16* KVS = (bf16*)(F.ws + WS_KVS); const bf16* META = (const bf16*)(F.ws + WS_META);
    int tid_ = F.tid; asm volatile("" : "+v"(tid_));
    int gt = F.vcu * 512 + tid_, NT_ = F.G * 512;
#if ATT_V2
    if ((F.G & 31) == 0) { const int sl = F.vcu & 31, q = sl & 15; if (q < 4 || q >= 12) return; gt = (((F.vcu >> 5) * 16 + (sl >> 4) * 8 + (q - 4)) * 512) + tid_; NT_ = (F.G >> 1) * 512; }
#endif
    for (int it = gt; it < 16 * 2 * 256 * 16; it += NT_) {
        const int d8 = it & 15, e = (it >> 4) & 255, dir = (it >> 12) & 1, bh = it >> 13, h = bh & 3;
        const float lg = log2_gamma(dir == 0 ? F.in[IN_DECF][h] : F.in[IN_DECB][h]);
        const float g128 = exp2f(lg * 128.f);
        GAS v4u* p = (GAS v4u*)(KVS + (size_t)(bh * 2 + dir) * 32 * 32768 + e * 128 + d8 * 8);
        float s[8];
        if (dir == 0) { const v4u a = *(const GAS v4u*)(META + (size_t)h * 32768 + e * 128 + d8 * 8);
            s[0] = bflo(a.x); s[1] = bfhi(a.x); s[2] = bflo(a.y); s[3] = bfhi(a.y); s[4] = bflo(a.z); s[5] = bfhi(a.z); s[6] = bflo(a.w); s[7] = bfhi(a.w); }
        else {
#pragma unroll
            for (int k = 0; k < 8; ++k) s[k] = 0.f; }
#pragma unroll
        for (int half = 0; half < 2; ++half) {
            v4u t[16];
#pragma unroll
            for (int i = 0; i < 16; ++i) { const int c = dir == 0 ? (half * 16 + i) : (31 - half * 16 - i); t[i] = p[(size_t)c * 4096]; }
#pragma unroll
            for (int i = 0; i < 16; ++i) { const int c = dir == 0 ? (half * 16 + i) : (31 - half * 16 - i);
                v4u o; o.x = pk2(s[0], s[1]); o.y = pk2(s[2], s[3]); o.z = pk2(s[4], s[5]); o.w = pk2(s[6], s[7]); p[(size_t)c * 4096] = o;
                s[0] = s[0] * g128 + bflo(t[i].x); s[1] = s[1] * g128 + bfhi(t[i].x); s[2] = s[2] * g128 + bflo(t[i].y); s[3] = s[3] * g128 + bfhi(t[i].y);
                s[4] = s[4] * g128 + bflo(t[i].z); s[5] = s[5] * g128 + bfhi(t[i].z); s[6] = s[6] * g128 + bflo(t[i].w); s[7] = s[7] * g128 + bfhi(t[i].w); }
        }
    }
}

namespace att {
constexpr int D = 128, NW = 8, QBLK = 32, KVBLK = 64, NT = 65;
constexpr float THR = 8.f;
constexpr int LDK = NIN, LDO = 2048;
constexpr size_t SHM_V = KVBLK * D * 2, SHM_K = KVBLK * D * 2, SHM_ATTN = 2 * SHM_V + 2 * SHM_K + NW * 64 * 4;
#define KSWZ(row, colB) ((row) * 256 + ((colB) ^ (((row) & 15) << 4)))
__device__ __forceinline__ void partialSM(f32x16& p0, f32x16& p1, float& m_reg, float& mn, float& alpha) {
    constexpr float C = 1.4426950408889634f;
    float pmax = p0[0];
#pragma unroll
    for (int r = 1; r < 16; ++r) pmax = fmaxf(pmax, p0[r]);
#pragma unroll
    for (int r = 0; r < 16; ++r) pmax = fmaxf(pmax, p1[r]);
    { auto rr = __builtin_amdgcn_permlane32_swap(__float_as_uint(pmax), __float_as_uint(pmax), false, false);
      pmax = fmaxf(__uint_as_float(rr[0]), __uint_as_float(rr[1])); }
    if (__builtin_expect(__all(pmax - m_reg <= THR), 1)) { mn = m_reg; alpha = 1.f; }
    else { mn = fmaxf(m_reg, pmax); alpha = __builtin_amdgcn_exp2f((m_reg - mn) * C); m_reg = mn; }
    const float mnC = -mn * C;
#pragma unroll
    for (int r = 0; r < 16; ++r) p0[r] = fmaf(p0[r], C, mnC);
#pragma unroll
    for (int r = 0; r < 16; ++r) p1[r] = fmaf(p1[r], C, mnC);
#pragma unroll
    for (int r = 0; r < 16; ++r) p0[r] = __builtin_amdgcn_exp2f(p0[r]);
}
__device__ __forceinline__ void finishSM(f32x16& p0, f32x16& p1, float alpha, float& l_reg, bf16x8& pa0, bf16x8& pa1, bf16x8& pa2, bf16x8& pa3) {
#pragma unroll
    for (int r = 0; r < 16; ++r) p1[r] = __builtin_amdgcn_exp2f(p1[r]);
    float ps = 0;
#pragma unroll
    for (int r = 0; r < 16; ++r) ps += p0[r];
#pragma unroll
    for (int r = 0; r < 16; ++r) ps += p1[r];
    { auto rr = __builtin_amdgcn_permlane32_swap(__float_as_uint(ps), __float_as_uint(ps), false, false);
      ps = __uint_as_float(rr[0]) + __uint_as_float(rr[1]); }
    l_reg = l_reg * alpha + ps;
#define PK4(P, BASE, OUT) do { unsigned a0 = cvtpk(P[BASE + 0], P[BASE + 1]), a1 = cvtpk(P[BASE + 2], P[BASE + 3]);   \
    unsigned b0 = cvtpk(P[BASE + 4], P[BASE + 5]), b1 = cvtpk(P[BASE + 6], P[BASE + 7]);                              \
    auto r0 = __builtin_amdgcn_permlane32_swap(a0, b0, false, false); auto r1 = __builtin_amdgcn_permlane32_swap(a1, b1, false, false); \
    v4u w = {r0[0], r1[0], r0[1], r1[1]}; OUT = *reinterpret_cast<bf16x8*>(&w); } while (0)
    PK4(p0, 0, pa0); PK4(p0, 8, pa1); PK4(p1, 0, pa2); PK4(p1, 8, pa3);
#undef PK4
}
__device__ __forceinline__ void qkt(f32x16& p0, f32x16& p1, const bf16* Ks, const bf16x8* qr, int r32, int hi, float dq, float nslope, int mode) {
    if (mode == 1) {
#pragma unroll
        for (int r = 0; r < 16; ++r) { p0[r] = r < 8 ? 0.f : -1e30f; p1[r] = -1e30f; }
    } else if (mode >= 2) {
        const float s1 = mode == 2 ? -nslope : nslope, a0 = -s1 * dq, a1 = a0 + 32.f * s1;
#pragma unroll
        for (int r = 0; r < 16; ++r) { const float c = (float)((r & 3) + 8 * (r >> 2)); p0[r] = fmaf(c, s1, a0); p1[r] = fmaf(c, s1, a1); }
    } else {
#pragma unroll
        for (int r = 0; r < 16; ++r) { const float c = (float)((r & 3) + 8 * (r >> 2)); p0[r] = nslope * fabsf(dq - c); p1[r] = nslope * fabsf(dq - 32.f - c); }
    }
#pragma unroll
    for (int d0 = 0; d0 < 8; ++d0) { const int cb = (d0 * 16 + hi * 8) * 2;
        const bf16x8 b0 = *reinterpret_cast<const bf16x8*>((const char*)Ks + KSWZ(r32, cb));
        const bf16x8 b1 = *reinterpret_cast<const bf16x8*>((const char*)Ks + KSWZ(32 + r32, cb));
        p0 = __builtin_amdgcn_mfma_f32_32x32x16_bf16(b0, qr[d0], p0, 0, 0, 0);
        p1 = __builtin_amdgcn_mfma_f32_32x32x16_bf16(b1, qr[d0], p1, 0, 0, 0); }
}
__device__ __forceinline__ int v_st(int k, int c) { const int kk = (k & ~0xC) | ((k & 4) << 1) | ((k & 8) >> 1); return ((kk >> 3) * 4 + (c >> 5)) * 512 + ((kk & 7) * 32 + (c & 31)) * 2; }
__device__ __forceinline__ int v_rd_base(int lane) { return ((lane & 3) << 3) | (((lane >> 2) & 3) << 6) | (((lane >> 4) & 1) << 5) | (((lane >> 5) & 1) << 8); }
constexpr int v_rd_off(int d0, int ks, int half) { return d0 * 512 + ks * 4096 + half * 2048; }
template <int OFF> __device__ __forceinline__ s16x4 tr_read(int vb) {
    s16x4 r; asm volatile("ds_read_b64_tr_b16 %0, %1 offset:%2" : "=&v"(r) : "v"(vb), "i"(OFF) : "memory"); return r;
}
template <int D0> __device__ __forceinline__ void pv_one(f32x16& od, int vb, bf16x8 pa0, bf16x8 pa1, bf16x8 pa2, bf16x8 pa3) {
    const s16x4 l0 = tr_read<v_rd_off(D0, 0, 0)>(vb), h0 = tr_read<v_rd_off(D0, 0, 1)>(vb), l1 = tr_read<v_rd_off(D0, 1, 0)>(vb), h1 = tr_read<v_rd_off(D0, 1, 1)>(vb);
    const s16x4 l2 = tr_read<v_rd_off(D0, 2, 0)>(vb), h2 = tr_read<v_rd_off(D0, 2, 1)>(vb), l3 = tr_read<v_rd_off(D0, 3, 0)>(vb), h3 = tr_read<v_rd_off(D0, 3, 1)>(vb);
    asm volatile("s_waitcnt lgkmcnt(0)" ::: "memory"); SBAR();
#define PK(L, H) (bf16x8){L[0], L[1], L[2], L[3], H[0], H[1], H[2], H[3]}
    od = __builtin_amdgcn_mfma_f32_32x32x16_bf16(pa0, PK(l0, h0), od, 0, 0, 0);
    od = __builtin_amdgcn_mfma_f32_32x32x16_bf16(pa1, PK(l1, h1), od, 0, 0, 0);
    od = __builtin_amdgcn_mfma_f32_32x32x16_bf16(pa2, PK(l2, h2), od, 0, 0, 0);
    od = __builtin_amdgcn_mfma_f32_32x32x16_bf16(pa3, PK(l3, h3), od, 0, 0, 0);
#undef PK
}
__device__ __forceinline__ void pv_d0(f32x16* o, int vb, bf16x8 pa0, bf16x8 pa1, bf16x8 pa2, bf16x8 pa3) {
    pv_one<0>(o[0], vb, pa0, pa1, pa2, pa3); pv_one<1>(o[1], vb, pa0, pa1, pa2, pa3); pv_one<2>(o[2], vb, pa0, pa1, pa2, pa3); pv_one<3>(o[3], vb, pa0, pa1, pa2, pa3);
}
__device__ __forceinline__ void attn_unit(const bf16* __restrict__ Zb, unsigned qoff, unsigned kreal, unsigned vreal, unsigned kmeta, unsigned vmeta,
                                          bf16* __restrict__ Ob, int q0, float nslope, int jlo, int nreal, char* lds) {
    const __amdgpu_buffer_rsrc_t rs = __builtin_amdgcn_make_buffer_rsrc((void*)Zb, 0, (int)((TM + 64) * (size_t)NIN * 2), 0x00020000);
    int tid = threadIdx.x; asm volatile("" : "+v"(tid));
    const int wid = tid >> 6, lane = tid & 63, r32 = lane & 31, hi = lane >> 5;
    bf16* V_lds = (bf16*)lds; bf16* K_lds = (bf16*)(lds + 2 * SHM_V);
    float* ws = (float*)(lds + 2 * SHM_V + 2 * SHM_K) + wid * 64; float* li_l = ws; float* al_l = ws + 32;
    float m_reg = -1e30f, l_reg = 0; f32x16 o[4] = {}; bf16x8 qr[8];
    { const unsigned qo = qoff + (unsigned)((wid * QBLK + r32) * LDK + hi * 8) * 2u;
#pragma unroll
      for (int d0 = 0; d0 < 8; ++d0) qr[d0] = __builtin_bit_cast(bf16x8, __builtin_amdgcn_raw_buffer_load_b128(rs, qo + (unsigned)(d0 * 32), 0, 0)); }
    const float qpos = (float)(q0 + wid * QBLK + r32 - 4 * hi);
    const int sr = tid >> 4, sc = (tid & 15) * 8, vst0 = v_st(sr, sc), vst1 = v_st(32 + sr, sc);
    const unsigned lvo = (unsigned)(sr * LDK + sc) * 2u;
    const int vb0 = (int)(uintptr_t)V_lds + v_rd_base(lane);
    struct { bf16x8 vs0, vs1, ks0, ks1; } sr_[1];
#define TI(p) ((p) < nreal ? jlo + (p) : 64)
#define SLOAD(i, jt) do { const unsigned ko_ = (jt) < 64 ? kreal + (unsigned)(jt) * (unsigned)(KVBLK * LDK * 2) : kmeta; const unsigned vo_ = (jt) < 64 ? vreal + (unsigned)(jt) * (unsigned)(KVBLK * LDK * 2) : vmeta; \
    sr_[i].vs0 = __builtin_bit_cast(bf16x8, __builtin_amdgcn_raw_buffer_load_b128(rs, lvo, vo_, 0)); sr_[i].vs1 = __builtin_bit_cast(bf16x8, __builtin_amdgcn_raw_buffer_load_b128(rs, lvo, vo_ + (unsigned)(32 * LDK * 2), 0)); \
    sr_[i].ks0 = __builtin_bit_cast(bf16x8, __builtin_amdgcn_raw_buffer_load_b128(rs, lvo, ko_, 0)); sr_[i].ks1 = __builtin_bit_cast(bf16x8, __builtin_amdgcn_raw_buffer_load_b128(rs, lvo, ko_ + (unsigned)(32 * LDK * 2), 0)); } while (0)
#define SWRITE(b, i) do { *(bf16x8*)((char*)V_lds + (b) * SHM_V + vst0) = sr_[i].vs0;          \
    *(bf16x8*)((char*)V_lds + (b) * SHM_V + vst1) = sr_[i].vs1; int kc = sc * 2;               \
    *(bf16x8*)((char*)K_lds + (b) * SHM_K + KSWZ(sr, kc)) = sr_[i].ks0;                       \
    *(bf16x8*)((char*)K_lds + (b) * SHM_K + KSWZ(32 + sr, kc)) = sr_[i].ks1; } while (0)
#define SWAIT() asm volatile("s_waitcnt vmcnt(0)" ::: "memory")
#define RESC(a) do { if (__any((a) < 1.f)) { if (hi == 0) al_l[r32] = (a); asm volatile("s_waitcnt lgkmcnt(0)" ::: "memory"); \
    _Pragma("unroll") for (int d = 0; d < 4; ++d) _Pragma("unroll") for (int r = 0; r < 16; ++r) o[d][r] *= al_l[crow(r, hi)]; } } while (0)
#define DQ(jt) (qpos - (float)((jt) * KVBLK))
    const int qmin = q0 + QBLK * __builtin_amdgcn_readfirstlane(wid);
#define MODE(jt) ((jt) * KVBLK + KVBLK - 1 <= qmin ? 2 : ((jt) * KVBLK >= qmin + QBLK - 1 ? 3 : 0))
    f32x16 pA0, pA1, pB0, pB1; float mnA, mnB, alA, alB; bf16x8 pa0, pa1, pa2, pa3;
    constexpr int SE = 0, SO = 0;
    const int NTu = nreal + 1;
    SLOAD(SE, jlo); asm volatile("s_waitcnt vmcnt(0)" ::: "memory"); SWRITE(0, SE); __syncthreads();
    qkt(pA0, pA1, K_lds, qr, r32, hi, DQ(jlo), nslope, MODE(jlo)); partialSM(pA0, pA1, m_reg, mnA, alA);
    SLOAD(SO, jlo + 1);
    SWAIT(); SWRITE(1, SO); __syncthreads();
    for (int p = 1; p + 1 < NTu; p += 2) {
        const int tq = TI(p + 1), tn = TI(p + 2);
        SBAR(); qkt(pB0, pB1, (bf16*)((char*)K_lds + SHM_K), qr, r32, hi, DQ(jlo + p), nslope, MODE(jlo + p));
        finishSM(pA0, pA1, alA, l_reg, pa0, pa1, pa2, pa3); SBAR();
        SLOAD(SE, tq); SBAR();
        pv_d0(o, vb0, pa0, pa1, pa2, pa3); partialSM(pB0, pB1, m_reg, mnB, alB);
        __syncthreads(); SWAIT(); SWRITE(0, SE);
        RESC(alB); __syncthreads();
        SBAR(); qkt(pA0, pA1, K_lds, qr, r32, hi, DQ(tq), nslope, p + 1 == nreal ? 1 : MODE(tq));
        finishSM(pB0, pB1, alB, l_reg, pa0, pa1, pa2, pa3); SBAR();
        SLOAD(SO, tn); SBAR();
        pv_d0(o, vb0 + (int)SHM_V, pa0, pa1, pa2, pa3); partialSM(pA0, pA1, m_reg, mnA, alA);
        __syncthreads(); SWAIT(); SWRITE(1, SO);
        RESC(alA); __syncthreads();
    }
    finishSM(pA0, pA1, alA, l_reg, pa0, pa1, pa2, pa3); SBAR();
    pv_d0(o, vb0, pa0, pa1, pa2, pa3);
    if (hi == 0) li_l[r32] = l_reg; asm volatile("s_waitcnt lgkmcnt(0)" ::: "memory");
    float rli[16];
#pragma unroll
    for (int r = 0; r < 16; ++r) rli[r] = __builtin_amdgcn_rcpf(li_l[crow(r, hi)]);
    bf16* Ow = Ob + (long)(wid * QBLK) * LDO;
#pragma unroll
    for (int r = 0; r < 16; ++r) { const int orow = crow(r, hi);
#pragma unroll
        for (int d0 = 0; d0 < 4; ++d0) Ow[(long)orow * LDO + d0 * 32 + r32] = (bf16)f2bf(o[d0][r] * rli[r]); }
    __syncthreads();
#undef TI
#undef SLOAD
#undef SWRITE
#undef SWAIT
#undef RESC
#undef DQ
#undef MODE
}
}

__device__ __forceinline__ void p3_attention(Frame& F) {
    const bf16* Z = (const bf16*)(F.ws + WS_Z); bf16* OB = (bf16*)(F.ws + WS_OBUF);
    float gmq = 0.f, gmk = 0.f;
    for (int i = lane_id(); i < 128; i += 64) { gmq = fmaxf(gmq, fabsf(F.in[IN_QG][i])); gmk = fmaxf(gmk, fabsf(F.in[IN_KG][i])); }
#pragma unroll
    for (int o = 1; o < 64; o <<= 1) { gmq = fmaxf(gmq, __shfl_xor(gmq, o)); gmk = fmaxf(gmk, __shfl_xor(gmk, o)); }
    const float thr = 32.f + 2.05f * gmq * gmk * 11.3137085f;
    for (int u = F.vcu; u < 1024; u += F.G) {
        const int rnd = u >> 8, v = u & 255, x = v >> 5, sl = v & 31, qb = sl & 15, vh = sl >> 4, b = rnd, hm = (x + 2 * rnd) & 7, h = hm >> 1, m = hm & 1;
        const float slope = exp2f(-2.f * (float)(h + 1)), nslope = -slope;
        int jlo, nreal;
        { const float dkf = fminf(thr / slope, 100000.f); const int Dk = (int)dkf, q0 = 256 * qb;
          int lo = q0 - 63 - Dk; lo = lo <= 0 ? 0 : (lo + 63) >> 6; int hi_ = (q0 + 255 + Dk) >> 6; hi_ = hi_ > 63 ? 63 : hi_;
          if (((hi_ - lo + 1) & 1) != 0) { if (lo > 0) --lo; else ++hi_; }
          jlo = __builtin_amdgcn_readfirstlane(lo); nreal = __builtin_amdgcn_readfirstlane(hi_ - lo + 1); }
        const unsigned qoff = (unsigned)(((size_t)(b * SEQ + 256 * qb) * NIN + C_DQ + (2 * h + m) * 128) * 2);
        const unsigned kreal = (unsigned)(((size_t)(b * SEQ) * NIN + C_DK + (2 * h + m) * 128) * 2), vreal = (unsigned)(((size_t)(b * SEQ) * NIN + C_DV + h * 256 + vh * 128) * 2);
        const unsigned kmeta = (unsigned)(((size_t)T * NIN + C_DK + (2 * h + m) * 128) * 2), vmeta = (unsigned)(((size_t)T * NIN + C_DV + h * 256 + vh * 128) * 2);
        bf16* Ob = OB + (size_t)(b * SEQ + 256 * qb) * 2048 + m * 1024 + h * 256 + vh * 128;
        att::attn_unit(Z, qoff, kreal, vreal, kmeta, vmeta, Ob, 256 * qb, nslope, jlo, nreal, (char*)F.lds);
    }
}


namespace att2 {
using namespace att;
constexpr int SHM_K2 = 16384, SHM_V2 = 32768;
constexpr int LDS_V = 0, LDS_K = 2 * SHM_V2, LDS_WS = LDS_K + 2 * SHM_K2;
template <int D0> __device__ __forceinline__ void pv_one2(f32x16& od, int vb, bf16x8 pa0, bf16x8 pa1, bf16x8 pa2, bf16x8 pa3) {
    constexpr int IM = (D0 >> 2) * 16384, B = D0 & 3;
    const s16x4 l0 = tr_read<IM + v_rd_off(B, 0, 0)>(vb), h0 = tr_read<IM + v_rd_off(B, 0, 1)>(vb), l1 = tr_read<IM + v_rd_off(B, 1, 0)>(vb), h1 = tr_read<IM + v_rd_off(B, 1, 1)>(vb);
    const s16x4 l2 = tr_read<IM + v_rd_off(B, 2, 0)>(vb), h2 = tr_read<IM + v_rd_off(B, 2, 1)>(vb), l3 = tr_read<IM + v_rd_off(B, 3, 0)>(vb), h3 = tr_read<IM + v_rd_off(B, 3, 1)>(vb);
    asm volatile("s_waitcnt lgkmcnt(0)" ::: "memory"); SBAR();
#define PK(L, H) (bf16x8){L[0], L[1], L[2], L[3], H[0], H[1], H[2], H[3]}
    od = __builtin_amdgcn_mfma_f32_32x32x16_bf16(pa0, PK(l0, h0), od, 0, 0, 0);
    od = __builtin_amdgcn_mfma_f32_32x32x16_bf16(pa1, PK(l1, h1), od, 0, 0, 0);
    od = __builtin_amdgcn_mfma_f32_32x32x16_bf16(pa2, PK(l2, h2), od, 0, 0, 0);
    od = __builtin_amdgcn_mfma_f32_32x32x16_bf16(pa3, PK(l3, h3), od, 0, 0, 0);
#undef PK
}
struct VFrag { s16x4 l0, h0, l1, h1, l2, h2, l3, h3; };
template <int D0> __device__ __forceinline__ void pv_load(VFrag& f, int vb) {
    constexpr int IM = (D0 >> 2) * 16384, B = D0 & 3;
    f.l0 = tr_read<IM + v_rd_off(B, 0, 0)>(vb); f.h0 = tr_read<IM + v_rd_off(B, 0, 1)>(vb); f.l1 = tr_read<IM + v_rd_off(B, 1, 0)>(vb); f.h1 = tr_read<IM + v_rd_off(B, 1, 1)>(vb);
    f.l2 = tr_read<IM + v_rd_off(B, 2, 0)>(vb); f.h2 = tr_read<IM + v_rd_off(B, 2, 1)>(vb); f.l3 = tr_read<IM + v_rd_off(B, 3, 0)>(vb); f.h3 = tr_read<IM + v_rd_off(B, 3, 1)>(vb);
}
__device__ __forceinline__ void pv_mma(f32x16& od, const VFrag& f, bf16x8 pa0, bf16x8 pa1, bf16x8 pa2, bf16x8 pa3) {
#define PK(L, H) (bf16x8){L[0], L[1], L[2], L[3], H[0], H[1], H[2], H[3]}
    od = __builtin_amdgcn_mfma_f32_32x32x16_bf16(pa0, PK(f.l0, f.h0), od, 0, 0, 0);
    od = __builtin_amdgcn_mfma_f32_32x32x16_bf16(pa1, PK(f.l1, f.h1), od, 0, 0, 0);
    od = __builtin_amdgcn_mfma_f32_32x32x16_bf16(pa2, PK(f.l2, f.h2), od, 0, 0, 0);
    od = __builtin_amdgcn_mfma_f32_32x32x16_bf16(pa3, PK(f.l3, f.h3), od, 0, 0, 0);
#undef PK
}
#define PV_WAIT8() do { asm volatile("s_waitcnt lgkmcnt(8)" ::: "memory"); SBAR(); } while (0)
#define PV_WAIT0() do { asm volatile("s_waitcnt lgkmcnt(0)" ::: "memory"); SBAR(); } while (0)
__device__ __forceinline__ void attn_unit2(const bf16* __restrict__ Zb, unsigned qoff, unsigned kreal, unsigned vreal, unsigned kmeta, unsigned vmeta,
                                           bf16* __restrict__ Ob, int q0, float nslope, int jlo, int nreal, bool with_meta, float* __restrict__ lse, char* lds) {
    const __amdgpu_buffer_rsrc_t rs = __builtin_amdgcn_make_buffer_rsrc((void*)Zb, 0, (int)((TM + 64) * (size_t)NIN * 2), 0x00020000);
    int tid = threadIdx.x; asm volatile("" : "+v"(tid));
    const int wid = tid >> 6, lane = tid & 63, r32 = lane & 31, hi = lane >> 5;
    char* V_lds = lds + LDS_V; char* K_lds = lds + LDS_K;
    float* ws = (float*)(lds + LDS_WS) + wid * 64; float* li_l = ws; float* al_l = ws + 32;
    float m_reg = -1e30f, l_reg = 0; f32x16 o[8] = {}; bf16x8 qr[8];
    { const unsigned qo = qoff + (unsigned)((wid * QBLK + r32) * LDK + hi * 8) * 2u;
#pragma unroll
      for (int d0 = 0; d0 < 8; ++d0) qr[d0] = __builtin_bit_cast(bf16x8, __builtin_amdgcn_raw_buffer_load_b128(rs, qo + (unsigned)(d0 * 32), 0, 0)); }
    const float qpos = (float)(q0 + wid * QBLK + r32 - 4 * hi);
    const int vb0 = (int)(uintptr_t)V_lds + v_rd_base(lane);
    const int wu = __builtin_amdgcn_readfirstlane(wid);
    const unsigned kl0 = (unsigned)((lane >> 4) * LDK) * 2u, kc0 = (unsigned)((lane & 15) ^ (lane >> 4));
    const unsigned vl0 = (unsigned)((8 * ((lane >> 4) & 1) + ((lane >> 2) & 3)) * LDK + 32 * (lane >> 5) + 8 * (lane & 3)) * 2u;
    const char* Zc = (const char*)Zb;
#define TI(p) ((p) < nreal ? jlo + (p) : 64)
#define DMA_TILE(jt, b) do { const unsigned ko_ = (jt) < 64 ? kreal + (unsigned)(jt) * (unsigned)(KVBLK * LDK * 2) : kmeta; const unsigned vo_ = (jt) < 64 ? vreal + (unsigned)(jt) * (unsigned)(KVBLK * LDK * 2) : vmeta; \
    _Pragma("unroll") for (int q_ = 0; q_ < 2; ++q_) { const int i_ = 2 * wu + q_; \
        __builtin_amdgcn_global_load_lds((const unsigned*)(Zc + ko_ + (unsigned)(4 * i_ * LDK * 2) + kl0 + ((kc0 ^ (unsigned)((4 * i_) & 15)) << 4)), (LAS unsigned*)(lds + LDS_K + (b) * SHM_K2 + i_ * 1024), 16, 0, 0); \
        const unsigned vu_ = (unsigned)((16 * (i_ >> 2) + 4 * ((i_ >> 1) & 1)) * LDK + 64 * (i_ & 1)) * 2u; \
        __builtin_amdgcn_global_load_lds((const unsigned*)(Zc + vo_ + vu_ + vl0), (LAS unsigned*)(lds + LDS_V + (b) * SHM_V2 + i_ * 1024), 16, 0, 0); \
        __builtin_amdgcn_global_load_lds((const unsigned*)(Zc + vo_ + vu_ + vl0 + 256u), (LAS unsigned*)(lds + LDS_V + (b) * SHM_V2 + 16384 + i_ * 1024), 16, 0, 0); } } while (0)
#define RESC(a) do { if (__any((a) < 1.f)) { if (hi == 0) al_l[r32] = (a); asm volatile("s_waitcnt lgkmcnt(0)" ::: "memory"); \
    _Pragma("unroll") for (int d = 0; d < 8; ++d) _Pragma("unroll") for (int r = 0; r < 16; ++r) o[d][r] *= al_l[crow(r, hi)]; } } while (0)
#define DQ(jt) (qpos - (float)((jt) * KVBLK))
    const int qmin = q0 + QBLK * __builtin_amdgcn_readfirstlane(wid);
#define MODE(jt) ((jt) * KVBLK + KVBLK - 1 <= qmin ? 2 : ((jt) * KVBLK >= qmin + QBLK - 1 ? 3 : 0))
    f32x16 p0, p1; float mn, al; bf16x8 pa0, pa1, pa2, pa3;
    const int NTu = nreal + (with_meta ? 1 : 0);
    DMA_TILE(jlo, 0); asm volatile("s_waitcnt vmcnt(0)" ::: "memory"); __syncthreads();
    for (int p = 0; p < NTu; ++p) {
        const int cur = p & 1, jt = TI(p), jn = TI(p + 1);
        DMA_TILE(jn, cur ^ 1);
        SBAR(); qkt(p0, p1, (const bf16*)(K_lds + cur * SHM_K2), qr, r32, hi, DQ(jt), nslope, p == nreal ? 1 : MODE(jt)); SBAR();
        partialSM(p0, p1, m_reg, mn, al);
        RESC(al);
        finishSM(p0, p1, al, l_reg, pa0, pa1, pa2, pa3); SBAR();
        { const int vb = vb0 + cur * SHM_V2; VFrag fa, fb;
          asm volatile("s_waitcnt lgkmcnt(0)" ::: "memory");
          pv_load<0>(fa, vb);
          pv_load<1>(fb, vb); PV_WAIT8(); pv_mma(o[0], fa, pa0, pa1, pa2, pa3);
          pv_load<2>(fa, vb); PV_WAIT8(); pv_mma(o[1], fb, pa0, pa1, pa2, pa3);
          pv_load<3>(fb, vb); PV_WAIT8(); pv_mma(o[2], fa, pa0, pa1, pa2, pa3);
          pv_load<4>(fa, vb); PV_WAIT8(); pv_mma(o[3], fb, pa0, pa1, pa2, pa3);
          pv_load<5>(fb, vb); PV_WAIT8(); pv_mma(o[4], fa, pa0, pa1, pa2, pa3);
          pv_load<6>(fa, vb); PV_WAIT8(); pv_mma(o[5], fb, pa0, pa1, pa2, pa3);
          pv_load<7>(fb, vb); PV_WAIT8(); pv_mma(o[6], fa, pa0, pa1, pa2, pa3);
          PV_WAIT0(); pv_mma(o[7], fb, pa0, pa1, pa2, pa3); }
        asm volatile("s_waitcnt vmcnt(0)" ::: "memory");
        __syncthreads();
    }
    if (hi == 0) li_l[r32] = l_reg; asm volatile("s_waitcnt lgkmcnt(0)" ::: "memory");
    if (lse != nullptr && hi == 0) lse[(long)(wid * QBLK + r32) * 8] = m_reg * 1.4426950408889634f + __builtin_amdgcn_logf(l_reg);
    float rli[16];
#pragma unroll
    for (int r = 0; r < 16; ++r) rli[r] = __builtin_amdgcn_rcpf(li_l[crow(r, hi)]);
    bf16* Ow = Ob + (long)(wid * QBLK) * LDO;
#pragma unroll
    for (int r = 0; r < 16; ++r) { const int orow = crow(r, hi);
#pragma unroll
        for (int d0 = 0; d0 < 8; ++d0) Ow[(long)orow * LDO + d0 * 32 + r32] = (bf16)f2bf(o[d0][r] * rli[r]); }
    __syncthreads();
#undef TI
#undef DMA_TILE
#undef RESC
#undef DQ
#undef MODE
}
}

__device__ __forceinline__ void p3_attention2(Frame& F) {
    const bf16* Z = (const bf16*)(F.ws + WS_Z); bf16* OB = (bf16*)(F.ws + WS_OBUF);
    float gmq = 0.f, gmk = 0.f;
    for (int i = lane_id(); i < 128; i += 64) { gmq = fmaxf(gmq, fabsf(F.in[IN_QG][i])); gmk = fmaxf(gmk, fabsf(F.in[IN_KG][i])); }
#pragma unroll
    for (int o = 1; o < 64; o <<= 1) { gmq = fmaxf(gmq, __shfl_xor(gmq, o)); gmk = fmaxf(gmk, __shfl_xor(gmk, o)); }
    const float thr = __builtin_bit_cast(float, __builtin_amdgcn_readfirstlane(__builtin_bit_cast(int, 32.f + 2.05f * gmq * gmk * 11.3137085f)));
    float* LSE = (float*)(F.ws + WS_LSE); bf16* OB2 = (bf16*)(F.ws + WS_OBUF2);
    if (!(F.vcu & 1)) p0_experts_q(F, CW_CONV + 192, CONV_SPLIT2, CONV_SPLIT3);
    for (int u = F.vcu;; ) {
        int b, h, m, qb, part = -1;
        if (u < 256) { const int x = u >> 5, sl = u & 31, g = 2 * x + (sl >> 4); b = g >> 2; h = 2 + ((g >> 1) & 1); m = g & 1; qb = sl & 15; }
        else {
            __syncthreads();
            if (F.tid == 0) F.MISC[20] = __hip_atomic_fetch_add(F.ctl + CW_ATT, 1u, __ATOMIC_RELAXED, __HIP_MEMORY_SCOPE_AGENT);
            __syncthreads();
            const int t = __builtin_amdgcn_readfirstlane((int)F.MISC[20]);
            if (t >= 384) break;
            if (t < 256) { const int qi = t >> 4, j = t & 15; qb = (qi & 1) ? 8 + (qi >> 1) : 7 - (qi >> 1); b = j >> 2; m = (j >> 1) & 1; part = j & 1; h = 1; }
            else { const int t2 = t - 256, qi = t2 >> 3, j = t2 & 7; qb = (qi & 1) ? 8 + (qi >> 1) : 7 - (qi >> 1); b = j >> 1; m = j & 1; h = 0; }
        }
        const float slope = exp2f(-2.f * (float)(h + 1)), nslope = -slope;
        int jlo, nreal; bool with_meta = true;
        { const float dkf = fminf(thr / slope, 100000.f); const int Dk = (int)dkf, q0 = 256 * qb;
          int lo = q0 - 63 - Dk; lo = lo <= 0 ? 0 : (lo + 63) >> 6; int hi_ = (q0 + 255 + Dk) >> 6; hi_ = hi_ > 63 ? 63 : hi_;
          if (part >= 0) { const int n = hi_ - lo + 1, na = (n + 1) >> 1; if (part == 0) hi_ = lo + na - 1; else { lo = lo + na; with_meta = false; } }
          jlo = __builtin_amdgcn_readfirstlane(lo); nreal = __builtin_amdgcn_readfirstlane(hi_ - lo + 1); }
        const unsigned qoff = (unsigned)(((size_t)(b * SEQ + 256 * qb) * NIN + C_DQ + (2 * h + m) * 128) * 2);
        const unsigned kreal = (unsigned)(((size_t)(b * SEQ) * NIN + C_DK + (2 * h + m) * 128) * 2), vreal = (unsigned)(((size_t)(b * SEQ) * NIN + C_DV + h * 256) * 2);
        const unsigned kmeta = (unsigned)(((size_t)T * NIN + C_DK + (2 * h + m) * 128) * 2), vmeta = (unsigned)(((size_t)T * NIN + C_DV + h * 256) * 2);
        bf16* Ob = (part == 1 ? OB2 : OB) + (size_t)(b * SEQ + 256 * qb) * 2048 + m * 1024 + h * 256;
        float* lsep = part >= 0 ? LSE + ((size_t)part * T + (size_t)(b * SEQ + 256 * qb)) * 8 + m * 4 + h : nullptr;
        att2::attn_unit2(Z, qoff, kreal, vreal, kmeta, vmeta, Ob, 256 * qb, nslope, jlo, nreal, with_meta, lsep, (char*)F.lds);
        if (u < 256 && !(u + F.G < 256) && (F.vcu & 1)) p0_experts_q(F, CW_CONV + 256, CONV_SPLIT3, CONV_SPLIT4);
        u = (u < 256 && u + F.G < 256) ? u + F.G : 256;
    }
}

__device__ __forceinline__ void p4_retention(Frame& F) {
    const bf16* Z = (const bf16*)(F.ws + WS_Z); const bf16* KVS = (const bf16*)(F.ws + WS_KVS); bf16* MIX = (bf16*)(F.ws + WS_MIX);
    LAS bf16* R0 = (LAS bf16*)F.lds;
    LAS bf16* R1 = (LAS bf16*)(F.lds + 128 * LDP * 2);
    LAS bf16* R2 = (LAS bf16*)(F.lds + (128 + 256) * LDP * 2);
    LAS float* SS = (LAS float*)(F.lds + (128 + 256 + 128) * LDP * 2);
    for (int u = F.vcu; u < 512; u += F.G) {
        int tid = F.tid, wid = F.wave; asm volatile("" : "+v"(tid)); asm volatile("" : "+s"(wid));
        const int lane = tid & 63, r32 = lane & 31, hi = lane >> 5, wi = wid >> 2, w4 = wid & 3;
        const int bh = u >> 5, c = u & 31, b = bh >> 2, h = bh & 3;
        const size_t row0 = (size_t)b * SEQ + 128 * c;
        const float lgf = log2_gamma(F.in[IN_DECF][h]), lgb = log2_gamma(F.in[IN_DECB][h]);
        const int i_t = tid >> 2, part = tid & 3;
        __syncthreads();
        v4u qw[4];
#pragma unroll
        for (int q = 0; q < 4; ++q) { qw[q] = *(const GAS v4u*)(Z + (row0 + i_t) * NIN + C_RQ + 128 * h + 32 * part + 8 * q);
            const v4u kk = *(const GAS v4u*)(Z + (row0 + i_t) * NIN + C_RK + 128 * h + 32 * part + 8 * q);
            *(LAS v4u*)(R0 + i_t * LDP + 32 * part + 8 * q) = qw[q]; *(LAS v4u*)(R1 + i_t * LDP + 32 * part + 8 * q) = kk; }
        v4u vreg[8], sfr[8], sbr[8];
        { const bf16* vsrc = Z + (row0 + i_t) * NIN + C_RV + 256 * h + part * 64;
          const bf16* Sf = KVS + ((size_t)(bh * 2 + 0) * 32 + c) * 32768; const bf16* Sb = KVS + ((size_t)(bh * 2 + 1) * 32 + c) * 32768;
#pragma unroll
          for (int q = 0; q < 8; ++q) { vreg[q] = *(const GAS v4u*)(vsrc + 8 * q); sfr[q] = *(const GAS v4u*)(Sf + (q * 512 + tid) * 8); sbr[q] = *(const GAS v4u*)(Sb + (q * 512 + tid) * 8); } }
        __syncthreads();
        {
            f32x16 s[2][1]; s[0][0] = (f32x16){}; s[1][0] = (f32x16){};
            lds_mma<2, 1>(s, R0 + (64 * wi) * LDP, LDP, R1 + (32 * w4) * LDP, LDP, 128, lane);
            const int jj = 32 * w4 + r32;
#pragma unroll
            for (int mi = 0; mi < 2; ++mi)
#pragma unroll
                for (int r = 0; r < 16; ++r) { const int ii = 64 * wi + 32 * mi + crow(r, hi);
                    const float dec = jj <= ii ? exp2f(lgf * (float)(ii - jj)) : exp2f(lgb * (float)(jj - ii));
                    R2[ii * LDP + jj] = (bf16)f2bf(s[mi][0][r] * dec); }
        }
        __syncthreads();
#pragma unroll
        for (int q = 0; q < 8; ++q) { const v4u w = vreg[q]; const int c0 = part * 64 + 8 * q;
            R1[(c0 + 0) * LDP + i_t] = (bf16)(w.x & 0xffffu); R1[(c0 + 1) * LDP + i_t] = (bf16)(w.x >> 16);
            R1[(c0 + 2) * LDP + i_t] = (bf16)(w.y & 0xffffu); R1[(c0 + 3) * LDP + i_t] = (bf16)(w.y >> 16);
            R1[(c0 + 4) * LDP + i_t] = (bf16)(w.z & 0xffffu); R1[(c0 + 5) * LDP + i_t] = (bf16)(w.z >> 16);
            R1[(c0 + 6) * LDP + i_t] = (bf16)(w.w & 0xffffu); R1[(c0 + 7) * LDP + i_t] = (bf16)(w.w >> 16); }
        __syncthreads();
        f32x16 acc[2][2];
#pragma unroll
        for (int a = 0; a < 2; ++a)
#pragma unroll
            for (int bb = 0; bb < 2; ++bb) acc[a][bb] = (f32x16){};
        lds_mma<2, 2>(acc, R2 + (64 * wi) * LDP, LDP, R1 + (64 * w4) * LDP, LDP, 128, lane);
        for (int dir = 0; dir < 2; ++dir) {
            __syncthreads();
            const float qd = dir == 0 ? exp2f(lgf * (float)(i_t + 1)) : exp2f(lgb * (float)(128 - i_t));
#pragma unroll
            for (int q = 0; q < 4; ++q) { v4u w; w.x = pk2(bflo(qw[q].x) * qd, bfhi(qw[q].x) * qd); w.y = pk2(bflo(qw[q].y) * qd, bfhi(qw[q].y) * qd);
                w.z = pk2(bflo(qw[q].z) * qd, bfhi(qw[q].z) * qd); w.w = pk2(bflo(qw[q].w) * qd, bfhi(qw[q].w) * qd);
                *(LAS v4u*)(R0 + i_t * LDP + 32 * part + 8 * q) = w; }
#pragma unroll
            for (int q = 0; q < 8; ++q) { const int idx = (q * 512 + tid) * 8; const int e = idx >> 7, d = idx & 127;
                *(LAS v4u*)(R1 + e * LDP + d) = dir == 0 ? sfr[q] : sbr[q]; }
            __syncthreads();
            lds_mma<2, 2>(acc, R0 + (64 * wi) * LDP, LDP, R1 + (64 * w4) * LDP, LDP, 128, lane);
        }
        const f32x4 g0 = *(const GAS f32x4*)(F.in[IN_RETG] + 256 * h + (tid & 31) * 8), g1 = *(const GAS f32x4*)(F.in[IN_RETG] + 256 * h + (tid & 31) * 8 + 4);
        v4u rgw[8];
#pragma unroll
        for (int q = 0; q < 8; ++q) { const int id = q * 512 + tid; rgw[q] = *(const GAS v4u*)(Z + (row0 + (id >> 5)) * NIN + C_RG + 256 * h + (id & 31) * 8); }
#pragma unroll
        for (int mi = 0; mi < 2; ++mi)
#pragma unroll
            for (int r = 0; r < 16; ++r) { float s = acc[mi][0][r] * acc[mi][0][r] + acc[mi][1][r] * acc[mi][1][r];
                s = red_x16(red16(s));
                if (r32 == 0) SS[(64 * wi + 32 * mi + crow(r, hi)) * 4 + w4] = s; }
        __syncthreads();
        if (tid < 128) { const float s = SS[tid * 4] + SS[tid * 4 + 1] + SS[tid * 4 + 2] + SS[tid * 4 + 3]; SS[512 + tid] = 1.f / sqrtf(s * (1.f / 256.f) + EPS); }
        __syncthreads();
        LAS float* OT = (LAS float*)F.lds;
#pragma unroll
        for (int mi = 0; mi < 2; ++mi)
#pragma unroll
            for (int r = 0; r < 16; ++r) { const int ii = 64 * wi + 32 * mi + crow(r, hi); const float rstd = SS[512 + ii];
                OT[ii * LDO_T + 64 * w4 + r32] = acc[mi][0][r] * rstd; OT[ii * LDO_T + 64 * w4 + 32 + r32] = acc[mi][1][r] * rstd; }
        __syncthreads();
#pragma unroll
        for (int q = 0; q < 8; ++q) { const int id = q * 512 + tid, ii = id >> 5, e0 = (id & 31) * 8;
            const f32x4 v0 = *(const LAS f32x4*)(OT + ii * LDO_T + e0), v1 = *(const LAS f32x4*)(OT + ii * LDO_T + e0 + 4);
            const v4u gw = rgw[q];
            const float x[8] = {bflo(gw.x), bfhi(gw.x), bflo(gw.y), bfhi(gw.y), bflo(gw.z), bfhi(gw.z), bflo(gw.w), bfhi(gw.w)};
            const float vv[8] = {v0.x * g0.x, v0.y * g0.y, v0.z * g0.z, v0.w * g0.w, v1.x * g1.x, v1.y * g1.y, v1.z * g1.z, v1.w * g1.w};
            float o[8];
#pragma unroll
            for (int e = 0; e < 8; ++e) o[e] = vv[e] * x[e] * __builtin_amdgcn_rcpf(1.f + __builtin_amdgcn_exp2f(-1.4426950408889634f * x[e]));
            v4u w; w.x = pk2(o[0], o[1]); w.y = pk2(o[2], o[3]); w.z = pk2(o[4], o[5]); w.w = pk2(o[6], o[7]);
            *(GAS v4u*)(MIX + (row0 + ii) * DM + 256 * h + e0) = w; }
    }
    __syncthreads();
}
__device__ __forceinline__ void p4_attn_post(Frame& F) {
    const bf16* OB = (const bf16*)(F.ws + WS_OBUF); bf16* MIX = (bf16*)(F.ws + WS_MIX);
    int lane = lane_id(); asm volatile("" : "+v"(lane));
    const int gw = F.vcu * NWAVES + F.wave, NGW = F.G * NWAVES;
    float a = 0.f, bsum = 0.f;
    for (int i = lane; i < 128; i += 64) { a += F.in[IN_LQ1][i] * F.in[IN_LK1][i]; bsum += F.in[IN_LQ2][i] * F.in[IN_LK2][i]; }
    const float lam = expf(wave_sum(a)) - expf(wave_sum(bsum)) + LAM_INIT;
    for (int m = gw; m < T; m += NGW) {
        const GAS v2u* o1 = (const GAS v2u*)(OB + (size_t)m * 2048) + lane;
        const GAS v2u* o2 = (const GAS v2u*)(OB + (size_t)m * 2048 + 1024) + lane;
        const GAS f32x4* gp = (const GAS f32x4*)F.in[IN_DOG] + lane;
        GAS v2u* op = (GAS v2u*)(MIX + (size_t)m * DM + 1024) + lane;
#pragma unroll
        for (int h = 0; h < 4; ++h) { const v2u w1 = o1[64 * h], w2 = o2[64 * h]; const f32x4 g = gp[64 * h];
            f32x4 x1 = (f32x4){bflo(w1.x), bfhi(w1.x), bflo(w1.y), bfhi(w1.y)}, x2 = (f32x4){bflo(w2.x), bfhi(w2.x), bflo(w2.y), bfhi(w2.y)};
#if ATT_V2
            if (h == 1) {
                const bf16* OB2 = (const bf16*)(F.ws + WS_OBUF2); const float* LSE = (const float*)(F.ws + WS_LSE);
                const v2u u1 = *((const GAS v2u*)(OB2 + (size_t)m * 2048) + lane + 64 * h), u2 = *((const GAS v2u*)(OB2 + (size_t)m * 2048 + 1024) + lane + 64 * h);
                const f32x4 y1 = (f32x4){bflo(u1.x), bfhi(u1.x), bflo(u1.y), bfhi(u1.y)}, y2 = (f32x4){bflo(u2.x), bfhi(u2.x), bflo(u2.y), bfhi(u2.y)};
                const float la1 = LSE[(size_t)m * 8 + 0 * 4 + 1], lb1 = LSE[((size_t)T + m) * 8 + 0 * 4 + 1], la2 = LSE[(size_t)m * 8 + 1 * 4 + 1], lb2 = LSE[((size_t)T + m) * 8 + 1 * 4 + 1];
                const float wa1 = __builtin_amdgcn_rcpf(1.f + __builtin_amdgcn_exp2f(lb1 - la1)), wa2 = __builtin_amdgcn_rcpf(1.f + __builtin_amdgcn_exp2f(lb2 - la2));
                x1 = x1 * wa1 + y1 * (1.f - wa1); x2 = x2 * wa2 + y2 * (1.f - wa2);
            }
#endif
            const f32x4 v = x1 - x2 * lam; const float s = wave_sum((v.x * v.x + v.y * v.y) + (v.z * v.z + v.w * v.w));
            const float rstd = (1.f - LAM_INIT) / sqrtf(s * (1.f / 256.f) + EPS);
            v2u w; w.x = pk2(v.x * rstd * g.x, v.y * rstd * g.y); w.y = pk2(v.z * rstd * g.z, v.w * rstd * g.w); op[64 * h] = w; }
    }
}

__device__ __forceinline__ void p6_route(Frame& F) {
    const bf16* H1 = (const bf16*)(F.ws + WS_U); unsigned char* XT = F.ws + WS_XT;
    int* TOK = (int*)(F.ws + WS_TOK); float* GATE = (float*)(F.ws + WS_GATE); float* RS = (float*)(F.ws + WS_RS); int* SLOT = (int*)(F.ws + WS_SLOT);
    LAS float* part = (LAS float*)F.lds;
    LAS float* ssqp = (LAS float*)(F.lds + 2 * 4 * 32 * 33 * 4);
    const float* wr_ = F.in[IN_WR]; const float* gain = F.in[IN_FNG];
    for (int u = F.vcu; u < T / 64; u += F.G) {
        int tid = F.tid, wid = F.wave; asm volatile("" : "+v"(tid)); asm volatile("" : "+s"(wid));
        const int lane = tid & 63, bl = wid >> 2, kq = wid & 3, i = lane & 31, kk = lane >> 5;
        const int row = u * 64 + bl * 32 + i;
        const bf16* hrow = H1 + (size_t)row * DM;
        f32x16 acc = (f32x16){}; float ssq = 0.f;
#pragma unroll 4
        for (int it = 0; it < 32; ++it) {
            const int k = 512 * kq + 16 * it + 8 * kk;
            const v4u hw = *(const GAS v4u*)(hrow + k);
            const f32x4 h0 = (f32x4){bflo(hw.x), bfhi(hw.x), bflo(hw.y), bfhi(hw.y)}, h1 = (f32x4){bflo(hw.z), bfhi(hw.z), bflo(hw.w), bfhi(hw.w)};
            const f32x4 g0 = *(const GAS f32x4*)(gain + k), g1 = *(const GAS f32x4*)(gain + k + 4);
            const f32x4 a0 = h0 * g0, a1 = h1 * g1;
            ssq += (h0.x * h0.x + h0.y * h0.y) + (h0.z * h0.z + h0.w * h0.w) + (h1.x * h1.x + h1.y * h1.y) + (h1.z * h1.z + h1.w * h1.w);
#if MOE_FP8
            { v2u w; w.x = pk4_fp8(a0.x * FP8_SX, a0.y * FP8_SX, a0.z * FP8_SX, a0.w * FP8_SX); w.y = pk4_fp8(a1.x * FP8_SX, a1.y * FP8_SX, a1.z * FP8_SX, a1.w * FP8_SX);
              *(GAS v2u*)(XT + (size_t)row * DM + k) = w; }
#else
            { v4u w; w.x = pk2(a0.x, a0.y); w.y = pk2(a0.z, a0.w); w.z = pk2(a1.x, a1.y); w.w = pk2(a1.z, a1.w);
              *(GAS v4u*)(XT + ((size_t)row * DM + k) * 2) = w; }
#endif
            const float av[8] = {a0.x, a0.y, a0.z, a0.w, a1.x, a1.y, a1.z, a1.w};
#pragma unroll
            for (int e = 0; e < 8; ++e) { const float bw = wr_[(size_t)(k + e) * NE + i]; acc = __builtin_amdgcn_mfma_f32_32x32x2f32(av[e], bw, acc, 0, 0, 0); }
        }
        ssq = red_x32(ssq);
        __syncthreads();
#pragma unroll
        for (int r = 0; r < 16; ++r) part[((bl * 4 + kq) * 32 + crow(r, kk)) * 33 + i] = acc[r];
        if (kk == 0) ssqp[(bl * 4 + kq) * 32 + i] = ssq;
        __syncthreads();
        if (tid < 64) {
            const int b2 = tid >> 5, ii = tid & 31, tokn = u * 64 + tid;
            const float sq = ssqp[(b2 * 4 + 0) * 32 + ii] + ssqp[(b2 * 4 + 1) * 32 + ii] + ssqp[(b2 * 4 + 2) * 32 + ii] + ssqp[(b2 * 4 + 3) * 32 + ii];
            const float rstd = 1.f / sqrtf(sq * (1.f / DM) + EPS);
            float lg[NE];
#pragma unroll
            for (int e = 0; e < NE; ++e) { const float s = part[((b2 * 4 + 0) * 32 + ii) * 33 + e] + part[((b2 * 4 + 1) * 32 + ii) * 33 + e] + part[((b2 * 4 + 2) * 32 + ii) * 33 + e] + part[((b2 * 4 + 3) * 32 + ii) * 33 + e];
                lg[e] = s * rstd + F.in[IN_BR][e]; }
            int sel[TOPK]; float val[TOPK]; unsigned used = 0u;
#pragma unroll
            for (int k = 0; k < TOPK; ++k) { float best = -3.0e38f; int bi = 0;
#pragma unroll
                for (int e = 0; e < NE; ++e) { const bool ok = !((used >> e) & 1u) && lg[e] > best; best = ok ? lg[e] : best; bi = ok ? e : bi; }
                sel[k] = bi; val[k] = best; used |= 1u << bi; }
            float ex[TOPK], den = 0.f;
#pragma unroll
            for (int k = 0; k < TOPK; ++k) { ex[k] = expf(val[k] - val[0]); den += ex[k]; }
#pragma unroll
            for (int k = 0; k < TOPK; ++k) { const int e = sel[k];
                const unsigned pos = __hip_atomic_fetch_add(F.ctl + CW_CNT + 64 * e, 1u, __ATOMIC_RELAXED, __HIP_MEMORY_SCOPE_AGENT);
                const size_t s = (size_t)e * ECAP + pos;
                TOK[s] = tokn; GATE[s] = ex[k] / den; RS[s] = rstd; SLOT[tokn * 4 + k] = (int)s; }
        }
    }
    __syncthreads();
}
__device__ __forceinline__ void p9_combine(Frame& F) {
    MoeTab tb = moe_tab(F);
    const int* SLOT = (const int*)(F.ws + WS_SLOT);
    int lane = lane_id(); asm volatile("" : "+v"(lane));
    const int gw = F.vcu * NWAVES + F.wave, NGW = F.G * NWAVES;
#if Y_FP8
    const unsigned char* Y = F.ws + WS_Y;
    for (int m = gw; m < T; m += NGW) {
        size_t yr[4];
#pragma unroll
        for (int k = 0; k < 4; ++k) { const int s = SLOT[m * 4 + k]; const int e = s / ECAP, pos = s % ECAP; yr[k] = (size_t)(tb.rbase[e] + pos) * DM; }
        float* op = F.out + (size_t)m * DM; const bf16* hp = (const bf16*)(F.ws + WS_U) + (size_t)m * DM;
#pragma unroll
        for (int j = 0; j < 2; ++j) { const int col = 1024 * j + 16 * lane;
            v4u w[4];
#pragma unroll
            for (int k = 0; k < 4; ++k) w[k] = *(const GAS v4u*)(Y + yr[k] + col);
            f32x4 a[4];
            { const v4u h0 = *(const GAS v4u*)(hp + col), h1 = *(const GAS v4u*)(hp + col + 8);
              a[0] = (f32x4){bflo(h0.x), bfhi(h0.x), bflo(h0.y), bfhi(h0.y)}; a[1] = (f32x4){bflo(h0.z), bfhi(h0.z), bflo(h0.w), bfhi(h0.w)};
              a[2] = (f32x4){bflo(h1.x), bfhi(h1.x), bflo(h1.y), bfhi(h1.y)}; a[3] = (f32x4){bflo(h1.z), bfhi(h1.z), bflo(h1.w), bfhi(h1.w)}; }
            float acc[16];
#pragma unroll
            for (int i = 0; i < 16; ++i) acc[i] = 0.f;
#pragma unroll
            for (int k = 0; k < 4; ++k) { const unsigned ww[4] = {w[k].x, w[k].y, w[k].z, w[k].w};
#pragma unroll
                for (int q = 0; q < 4; ++q) { const f32x2 lo = __builtin_amdgcn_cvt_pk_f32_fp8(ww[q], false), hi = __builtin_amdgcn_cvt_pk_f32_fp8(ww[q], true);
                    acc[4 * q] += lo.x; acc[4 * q + 1] += lo.y; acc[4 * q + 2] += hi.x; acc[4 * q + 3] += hi.y; } }
#pragma unroll
            for (int q = 0; q < 4; ++q) { f32x4 o = a[q]; o.x += acc[4 * q] * (1.f / FP8_SY); o.y += acc[4 * q + 1] * (1.f / FP8_SY); o.z += acc[4 * q + 2] * (1.f / FP8_SY); o.w += acc[4 * q + 3] * (1.f / FP8_SY);
                *(GAS f32x4*)(op + col + 4 * q) = o; } }
    }
#else
    const bf16* Y = (const bf16*)(F.ws + WS_Y);
    for (int m = gw; m < T; m += NGW) {
        size_t yr[4];
#pragma unroll
        for (int k = 0; k < 4; ++k) { const int s = SLOT[m * 4 + k]; const int e = s / ECAP, pos = s % ECAP; yr[k] = (size_t)(tb.rbase[e] + pos) * DM; }
        float* op = F.out + (size_t)m * DM;
#pragma unroll
        for (int j = 0; j < 4; ++j) { const int col = 512 * j + 8 * lane;
            f32x4 a0 = *(const GAS f32x4*)(op + col), a1 = *(const GAS f32x4*)(op + col + 4);
#pragma unroll
            for (int k = 0; k < 4; ++k) { const v4u w = *(const GAS v4u*)(Y + yr[k] + col);
                a0.x += bflo(w.x); a0.y += bfhi(w.x); a0.z += bflo(w.y); a0.w += bfhi(w.y); a1.x += bflo(w.z); a1.y += bfhi(w.z); a1.z += bflo(w.w); a1.w += bfhi(w.w); }
            *(GAS f32x4*)(op + col) = a0; *(GAS f32x4*)(op + col + 4) = a1; }
    }
#endif
}

struct Args { const float* in[22]; float* out; unsigned char* ws; int ph_lo, ph_hi; };
__global__ void __launch_bounds__(NWAVES * 64, 2) fwd(Args args) {
    extern __shared__ __attribute__((aligned(16))) unsigned char lds[];
    Frame F;
    F.lds = (LAS unsigned char*)lds;
    F.MISC = (volatile LAS unsigned*)(F.lds + MISC_OFF);
    F.tid = threadIdx.x; F.wave = __builtin_amdgcn_readfirstlane(F.tid >> 6);
    F.G = gridDim.x; { const int bx = blockIdx.x; F.vcu = (F.G % 8 == 0) ? (bx % 8) * (F.G / 8) + bx / 8 : bx; }
    F.ws = args.ws; F.ctl = (gu32*)(args.ws + WS_CTL); F.out = args.out;
#pragma unroll
    for (int i = 0; i < 22; ++i) F.in[i] = args.in[i];
    for (int u = F.tid; u < (LDS_BYTES - MISC_OFF) / 4; u += NWAVES * 64) ((LAS unsigned*)(F.lds + MISC_OFF))[u] = 0u;
    __syncthreads();
    const int lo = args.ph_lo, hi = args.ph_hi;
    XcdBarrier bar; bar.bar = (unsigned*)(F.ctl + CW_BAR); bar.x = 0; bar.st = nullptr;
    if (hi - lo > 1) bar = xcd_barrier_post((unsigned*)(F.ctl + CW_BAR), F.MISC + 8);
#ifndef PHASE_MASK
#define PHASE_MASK 0x3ff
#endif
#define IN(k) (((PHASE_MASK >> (k)) & 1) && lo <= (k) && (k) < hi)
#define BOTH(k) (IN(k) && IN((k) + 1))
#define GRID_BAR() xcd_barrier(bar)
#ifndef PROBE_DUP
#define PROBE_DUP 0
#endif
#define DUP(k) ((PROBE_DUP >> (k)) & 1)

    if (IN(0)) { p0_prologue(F); if (BOTH(0)) GRID_BAR(); }
    if (IN(1)) {
        p1_meta_rows(F);
        if ((F.vcu & 31) < NCONV) p0_experts_q(F, CW_CONV, 0, CONV_SPLIT);
        DenseSched S{(const bf16*)(F.ws + WS_U), (const bf16*)(F.ws + WS_WIN), T / 256, NIN / 256, DM * 2, F.G, (int)blockIdx.x};
        EpiZ E{(bf16*)(F.ws + WS_Z), F.in[IN_QG], F.in[IN_KG], (LAS float*)(F.lds + 131072)};
        pg8::gemm_phase<EpiZ, DenseSched, false, false>(F.lds, DM * 2, S, E);
        p0_experts_q(F, CW_CONV + 64, CONV_SPLIT, CONV_SPLIT2);
        if (BOTH(1)) GRID_BAR();
    }
    if (IN(2)) { p2_fixup(F); p2_kvstates(F); if (DUP(2)) p2_kvstates(F); if (BOTH(2)) GRID_BAR(); }
    if (IN(3)) {
#ifndef NO_SCAN
        p3_scan(F);
#endif
#ifndef NO_ATT
#if ATT_V2
        p3_attention2(F); if (DUP(3)) p3_attention2(F);
        p0_experts_q(F, CW_CONV + 128, CONV_SPLIT4, CONV_TICKETS);
#else
        p3_attention(F); if (DUP(3)) p3_attention(F);
#endif
#endif
 if (BOTH(3)) GRID_BAR(); }
    if (IN(4)) {
#ifndef NO_RET
        p4_retention(F); if (DUP(4)) p4_retention(F);
#endif
#ifndef NO_POST
        p4_attn_post(F); if (DUP(10)) p4_attn_post(F);
#endif
 if (BOTH(4)) GRID_BAR(); }
    if (IN(5)) {
        DenseSched S{(const bf16*)(F.ws + WS_MIX), (const bf16*)(F.ws + WS_WOUT), T / 256, DM / 256, DM * 2, F.G, (int)blockIdx.x};
        EpiOut E{F.in[IN_X], (bf16*)(F.ws + WS_U)};
        pg8::gemm_phase<EpiOut, DenseSched, false, false>(F.lds, DM * 2, S, E); if (DUP(5)) pg8::gemm_phase<EpiOut, DenseSched, false, false>(F.lds, DM * 2, S, E);
        if (BOTH(5)) GRID_BAR();
    }
    if (IN(6)) { p6_route(F); if (BOTH(6)) GRID_BAR(); }
    if (IN(7)) {
        moe_build_tables(F);
        MoeTab tb = moe_tab(F);
        constexpr int EB = MOE_FP8 ? 1 : 2;
        MoeSched S{F.ws + WS_XT, F.ws + WS_WGU, (size_t)4096 * DM * EB, 16, DM * EB, F.G, (int)blockIdx.x, tb, (const int*)(F.ws + WS_TOK)};
        EpiAct E{F.ws + WS_ACT, F.in[IN_BGU], (const float*)(F.ws + WS_RS), tb, F.lds};
        pg8::gemm_phase<EpiAct, MoeSched, true, MOE_FP8 != 0>(F.lds, DM * EB, S, E); if (DUP(7)) pg8::gemm_phase<EpiAct, MoeSched, true, MOE_FP8 != 0>(F.lds, DM * EB, S, E);
        if (BOTH(7)) GRID_BAR();
    }
    if (IN(8)) {
        if (!IN(7)) moe_build_tables(F);
        MoeTab tb = moe_tab(F);
        constexpr int EB = MOE_FP8 ? 1 : 2;
        MoeSched S{F.ws + WS_ACT, F.ws + WS_WD, (size_t)DM * DFF * EB, 8, DFF * EB, F.G, (int)blockIdx.x, tb, nullptr};
        EpiY E{F.ws + WS_Y, F.in[IN_BD], (const float*)(F.ws + WS_GATE), tb, F.lds};
        pg8::gemm_phase<EpiY, MoeSched, false, MOE_FP8 != 0>(F.lds, DFF * EB, S, E); if (DUP(8)) pg8::gemm_phase<EpiY, MoeSched, false, MOE_FP8 != 0>(F.lds, DFF * EB, S, E);
        if (BOTH(8)) GRID_BAR();
    }
    if (IN(9)) { if (!IN(8)) moe_build_tables(F); p9_combine(F); }
#undef IN
#undef BOTH
#undef GRID_BAR
}

extern "C" void kernel_launch(void* const* d_in, const int* in_sizes, int n_in, void* d_out, int out_size, void* d_ws, size_t ws_size, hipStream_t stream) {
    static int grid = 0;
    if (grid == 0) {
        if (n_in != 22 || out_size != T * DM || ws_size < WS_END) { fprintf(stderr, "kernel_launch: unexpected shapes (n_in %d out %d ws %zu)\n", n_in, out_size, ws_size); grid = -1; return; }
        int dev = 0, cus = 0;
        if (hipGetDevice(&dev) != hipSuccess || hipDeviceGetAttribute(&cus, hipDeviceAttributeMultiprocessorCount, dev) != hipSuccess) { grid = -1; return; }
        if (hipFuncSetAttribute((const void*)fwd, hipFuncAttributeMaxDynamicSharedMemorySize, LDS_BYTES) != hipSuccess) { fprintf(stderr, "kernel_launch: hipFuncSetAttribute failed\n"); grid = -1; return; }
        int per_cu = 0;
        if (hipOccupancyMaxActiveBlocksPerMultiprocessor(&per_cu, (const void*)fwd, NWAVES * 64, LDS_BYTES) != hipSuccess || per_cu < 1) fprintf(stderr, "kernel_launch: occupancy query says %d\n", per_cu);
        (void)hipGetLastError();
        grid = cus;
    }
    if (grid < 0) return;
    (void)hipMemsetAsync((char*)d_ws + WS_CTL, 0, CTL_ZERO_BYTES, stream);
    Args a{};
    for (int i = 0; i < 22; ++i) a.in[i] = (const float*)d_in[i];
    a.out = (float*)d_out; a.ws = (unsigned char*)d_ws;
#if MK_SPLIT
    for (int p = 0; p < NPHASE; ++p) { a.ph_lo = p; a.ph_hi = p + 1; hipLaunchKernelGGL(fwd, dim3(grid), dim3(NWAVES * 64), LDS_BYTES, stream, a); }
#else
    a.ph_lo = 0; a.ph_hi = NPHASE; hipLaunchKernelGGL(fwd, dim3(grid), dim3(NWAVES * 64), LDS_BYTES, stream, a);
#endif
    const hipError_t le = hipPeekAtLastError();
    if (le != hipSuccess) fprintf(stderr, "kernel_launch: launch failed: %s\n", hipGetErrorName(le));
}
```

```cpp
#include <hip/hip_runtime.h>
#include <cstdio>
#include <cstdint>

#ifndef MK_SPLIT
#define MK_SPLIT 0
#endif

#ifndef ATT_V2
#define ATT_V2 1
#endif
#ifndef Y_FP8
#define Y_FP8 1
#endif
#ifndef MOE_FP8
#define MOE_FP8 1
#endif
#define GAS __attribute__((address_space(1)))
#define LAS __attribute__((address_space(3)))
typedef unsigned short bf16;
typedef unsigned v4u __attribute__((ext_vector_type(4)));
typedef unsigned v2u __attribute__((ext_vector_type(2)));
typedef float f32x2 __attribute__((ext_vector_type(2)));
typedef float f32x4 __attribute__((ext_vector_type(4)));
typedef float f32x8 __attribute__((ext_vector_type(8)));
typedef float f32x16 __attribute__((ext_vector_type(16)));
typedef short bf16x8 __attribute__((ext_vector_type(8)));
typedef short s16x4 __attribute__((ext_vector_type(4)));
typedef GAS unsigned gu32;

constexpr int BATCH = 4, SEQ = 4096, DM = 2048, NMETA = 16;
constexpr int T = BATCH * SEQ;
constexpr int TM = T + 256;
constexpr int NIN = 6144;
constexpr int C_RQ = 0, C_RK = 512, C_RV = 1024, C_RG = 2048, C_DQ = 3072, C_DK = 4096, C_DV = 5120;
constexpr int NE = 32, TOPK = 4, DFF = 2048;
constexpr int ECAP = T;
constexpr int MAXTILES = (T * TOPK) / 256 + NE;
constexpr float EPS = 1e-6f;
constexpr float LAM_INIT = 0.2f;
constexpr int NPHASE = 10;

constexpr size_t MiB = 1u << 20;
constexpr size_t WS_CTL = 0, CTL_ZERO_BYTES = 1 * MiB;
constexpr size_t WS_WIN = 1 * MiB;
constexpr size_t WS_WOUT = 25 * MiB;
constexpr size_t WS_WGU = 33 * MiB;
constexpr size_t WS_WD = 545 * MiB;
constexpr size_t WS_U = 801 * MiB;
constexpr size_t WS_Z = 866 * MiB;
constexpr size_t WS_KVS = 1062 * MiB;
constexpr size_t WS_META = WS_KVS + 128 * MiB;
constexpr size_t WS_OBUF = 1191 * MiB;
constexpr size_t WS_OBUF2 = WS_OBUF + 64 * MiB;
constexpr size_t WS_LSE = 1454 * MiB;
constexpr size_t WS_MIX = 1319 * MiB;
constexpr size_t WS_XT = 1383 * MiB;
constexpr size_t WS_TOK = 1447 * MiB;
constexpr size_t WS_GATE = 1449 * MiB;
constexpr size_t WS_RS = 1451 * MiB;
constexpr size_t WS_SLOT = 1453 * MiB;
constexpr size_t WS_ACT = 1455 * MiB;
constexpr size_t WS_Y = 1743 * MiB;
constexpr size_t WS_END = 2031 * MiB;
constexpr int CW_TMO = 0;
constexpr int CW_BAR = 4096;
constexpr int CW_CNT = 16384;
constexpr int CW_CONV = 28672;
constexpr int CW_ATT = 24576;
constexpr int CW_Q1 = 20480;
#ifndef NCONV
#define CONV_P1 0
#define CONV_P2 8
#define CONV_P3 51
#define CONV_P4 94
#define CONV_SPLIT3 ((CONV_TICKETS * CONV_P3) / 100)
#define CONV_SPLIT4 ((CONV_TICKETS * CONV_P4) / 100)
#define CONV_SPLIT ((CONV_TICKETS * CONV_P1) / 100)
#define CONV_SPLIT2 ((CONV_TICKETS * CONV_P2) / 100)
#define NCONV 16
#endif

constexpr int LDS_BYTES = 163840;
constexpr int SCR_BYTES = 155648;
constexpr int TAB_OFF = SCR_BYTES;
constexpr int MISC_OFF = SCR_BYTES + 4096;
constexpr int EPF_OFF = 139264;
constexpr int NWAVES = 8;

#define LDS_WAIT() asm volatile("s_waitcnt lgkmcnt(0)" ::: "memory")
#define VM_WAIT() asm volatile("s_waitcnt vmcnt(0)" ::: "memory")
#define SBAR() __builtin_amdgcn_sched_barrier(0)

__device__ __forceinline__ unsigned f2bf(float f) { unsigned u = __builtin_bit_cast(unsigned, f); return (u + 0x7fffu + ((u >> 16) & 1u)) >> 16; }
__device__ __forceinline__ unsigned pk2(float lo, float hi) { unsigned r; asm("v_cvt_pk_bf16_f32 %0, %1, %2" : "=v"(r) : "v"(lo), "v"(hi)); return r; }
__device__ __forceinline__ float bf2f(unsigned b) { return __builtin_bit_cast(float, b << 16); }
__device__ __forceinline__ float bflo(unsigned w) { return __builtin_bit_cast(float, w << 16); }
__device__ __forceinline__ float bfhi(unsigned w) { return __builtin_bit_cast(float, w & 0xffff0000u); }
__device__ __forceinline__ unsigned cvtpk(float lo, float hi) { unsigned r; asm volatile("v_cvt_pk_bf16_f32 %0, %1, %2" : "=v"(r) : "v"(lo), "v"(hi)); return r; }
__device__ __forceinline__ float clamp448(float x) { return fminf(fmaxf(x, -448.f), 448.f); }
__device__ __forceinline__ unsigned pk4_fp8(float a, float b, float c, float d) {
    unsigned w = 0; w = __builtin_amdgcn_cvt_pk_fp8_f32(clamp448(a), clamp448(b), w, false); w = __builtin_amdgcn_cvt_pk_fp8_f32(clamp448(c), clamp448(d), w, true); return w; }
constexpr float FP8_SW = 512.f, FP8_SX = 8.f, FP8_SA = 4.f, FP8_SY = 32.f;
__device__ __forceinline__ int lane_id() { int l = threadIdx.x & 63; asm volatile("" : "+v"(l)); return l; }
__device__ __forceinline__ int crow(int r, int hi) { return (r & 3) + 8 * (r >> 2) + 4 * hi; }
template <int CTRL> __device__ __forceinline__ float dpp_mov(float v) { return __builtin_bit_cast(float, __builtin_amdgcn_update_dpp(0, __builtin_bit_cast(int, v), CTRL, 0xf, 0xf, true)); }
__device__ __forceinline__ float red16(float v) {
    v += dpp_mov<0xB1>(v); v += dpp_mov<0x4E>(v); v += dpp_mov<0x141>(v); v += dpp_mov<0x140>(v); return v; }
__device__ __forceinline__ float red_x16(float v) {
    float a = v, b = v; asm volatile("s_nop 1\n\tv_permlane16_swap_b32 %0, %1\n\ts_nop 1" : "+v"(a), "+v"(b)); return a + b; }
__device__ __forceinline__ float red_x32(float v) {
    float a = v, b = v; asm volatile("s_nop 1\n\tv_permlane32_swap_b32 %0, %1\n\ts_nop 1" : "+v"(a), "+v"(b)); return a + b; }
__device__ __forceinline__ float wave_sum(float v) {
    return red_x32(red_x16(red16(v)));
}

#define XB_TMO      128
#define XB_XCNT(j)  (256  + 64 * (j))
#define XB_XSUB(j)  (1280 + 64 * (j))
#define XB_XGEN(j)  (2304 + 64 * (j))
#define XB_TOP      3328
#define XB_TOPGEN   3392
#define XCD_BAR_WORDS 3456
#define XB_SPIN_CAP (1u << 18)
__device__ __forceinline__ unsigned xb_ld(unsigned* p)              { return __hip_atomic_load(p, __ATOMIC_RELAXED, __HIP_MEMORY_SCOPE_AGENT); }
__device__ __forceinline__ unsigned xb_add(unsigned* p, unsigned v) { return __hip_atomic_fetch_add(p, v, __ATOMIC_RELAXED, __HIP_MEMORY_SCOPE_AGENT); }
__device__ __forceinline__ unsigned xb_xcc_id() { return (unsigned)__builtin_amdgcn_s_getreg((3 << 11) | 20) & 0xFu; }
#define XB_SPIN(cond, bar) do { unsigned _sp = 0; while (cond) { __builtin_amdgcn_s_sleep(1); \
    if ((++_sp & 255u) == 0u) { if (xb_ld(&(bar)[XB_TMO])) break; if (_sp > XB_SPIN_CAP) { atomicAdd(&(bar)[XB_TMO], 1u); break; } } } } while (0)
struct XcdBarrier { unsigned* bar; unsigned x; volatile LAS unsigned* st; };
__device__ __forceinline__ XcdBarrier xcd_barrier_post(unsigned* bar, volatile LAS unsigned* st) {
    XcdBarrier b; b.bar = bar; b.x = xb_xcc_id(); b.st = st;
    if (threadIdx.x == 0) (void)xb_add(&bar[XB_XCNT(b.x)], 1u);
    return b;
}
__device__ __forceinline__ void xcd_barrier_complete(unsigned* bar, unsigned x, unsigned& nloc, unsigned& nx) {
    const unsigned G = gridDim.x * gridDim.y * gridDim.z;
    unsigned sum, cnt, mine, sp = 0u;
    for (;;) {
        sum = 0u; cnt = 0u; mine = 0u;
#pragma unroll
        for (unsigned j = 0; j < 16; ++j) { const unsigned c = xb_ld(&bar[XB_XCNT(j)]); sum += c; cnt += (c > 0u) ? 1u : 0u; mine = (j == x) ? c : mine; }
        if (sum == G) break;
        __builtin_amdgcn_s_sleep(1);
        if ((++sp & 255u) == 0u) { if (xb_ld(&bar[XB_TMO])) break; if (sp > XB_SPIN_CAP) { atomicAdd(&bar[XB_TMO], 1u); break; } }
    }
    nloc = mine > 0u ? mine : 1u; nx = cnt > 0u ? cnt : 1u;
}
__device__ __forceinline__ void xcd_barrier(const XcdBarrier& b) {
    asm volatile("s_waitcnt vmcnt(0)" ::: "memory");
    __syncthreads();
    if (threadIdx.x == 0) {
        unsigned* bar = b.bar;
        __builtin_amdgcn_s_waitcnt(0);
        unsigned nloc = b.st[0], nx = b.st[1];
        if (nloc == 0u) { xcd_barrier_complete(bar, b.x, nloc, nx); b.st[0] = nloc; b.st[1] = nx; }
        const unsigned old = xb_add(&bar[XB_XSUB(b.x)], 1u);
        const unsigned gen = old / nloc;
        if (old + 1u == (gen + 1u) * nloc) {
            __builtin_amdgcn_fence(__ATOMIC_RELEASE, "agent");
            asm volatile("s_waitcnt vmcnt(0)" ::: "memory");
            const unsigned og = xb_add(&bar[XB_TOP], 1u);
            const unsigned tg = og / nx;
            if (og + 1u == (tg + 1u) * nx) xb_add(&bar[XB_TOPGEN], 1u);
            else XB_SPIN(xb_ld(&bar[XB_TOPGEN]) == tg, bar);
            __builtin_amdgcn_fence(__ATOMIC_ACQUIRE, "agent");
            xb_add(&bar[XB_XGEN(b.x)], 1u);
            asm volatile("s_waitcnt vmcnt(0)" ::: "memory");
        } else {
            XB_SPIN(xb_ld(&bar[XB_XGEN(b.x)]) == gen, bar);
            __builtin_amdgcn_fence(__ATOMIC_ACQUIRE, "agent");
            asm volatile("s_waitcnt vmcnt(0)" ::: "memory");
        }
    }
    __syncthreads();
}

#ifndef PG8_SP2
#define PG8_SP2 true
#endif
#ifndef PG8_ALIGN
#define PG8_ALIGN true
#endif
namespace pg8 {
constexpr int BM = 256, BK = 64, HALF = 128, HTB = HALF * BK * 2, STAGE_BYTES = 8 * HTB, NXCD = 8, WGM = 8;
__host__ __device__ __forceinline__ int lds_byte(int r, int c) { return r * 128 + ((((c >> 3)) ^ ((r >> 1) & 7)) << 4) + (c & 7) * 2; }
__host__ __device__ __forceinline__ void stage_rc(int b, int& R, int& C) { R = b >> 7; C = ((((b >> 4) & 7) ^ ((R >> 1) & 7)) << 3) + ((b & 15) >> 1); }
__host__ __device__ __forceinline__ int perm32(int rho) { const int n = rho >> 4, i = rho & 15; return 8 * (i >> 2) + 4 * n + (i & 3); }
struct Unit { int pm, pn, e; };
__device__ __forceinline__ bool order_next(int i, int G, int c, int nM, int nN, int& pm, int& pn) {
    const int nwg = nM * nN; const long L = (long)i * G + c; if (L >= nwg) return false;
    int wgid = (int)L; { const int q = nwg / NXCD, r = nwg % NXCD, xcd = wgid % NXCD, off = wgid / NXCD; wgid = (xcd < r ? xcd * (q + 1) : r * (q + 1) + (xcd - r) * q) + off; }
    const int nig = WGM * nN, gid = wgid / nig, fm = gid * WGM, gsz = (nM - fm) < WGM ? (nM - fm) : WGM;
    pm = fm + ((wgid % nig) % gsz); pn = (wgid % nig) / gsz; return true;
}

typedef int i32x8 __attribute__((ext_vector_type(8)));
__device__ __forceinline__ i32x8 cat16(bf16x8 lo, bf16x8 hi) { const v4u a = __builtin_bit_cast(v4u, lo), b = __builtin_bit_cast(v4u, hi); return (i32x8){(int)a.x, (int)a.y, (int)a.z, (int)a.w, (int)b.x, (int)b.y, (int)b.z, (int)b.w}; }
template <class Epi, class Sched, bool GATHER, bool FP8, bool SP2 = PG8_SP2, bool ALIGN_EPI = PG8_ALIGN>
__device__ __forceinline__ void gemm_phase(LAS unsigned char* lds, const int pitchB, const Sched& S, const Epi& E) {
    const int tid = threadIdx.x, wid = __builtin_amdgcn_readfirstlane(tid >> 6), lane = tid & 63, wr = wid >> 2, wc = wid & 3, fr = lane & 15, fq = lane >> 4;
    const int nt = pitchB / 128;
    const size_t kstep = (size_t)128;
    const size_t hstep = (size_t)HALF * pitchB;
    unsigned voffB[2], voA[4];
#pragma unroll
    for (int i = 0; i < 2; ++i) { int R, C; stage_rc(tid * 16 + i * 8192, R, C); const int Rb = Epi::PERM ? ((R & ~31) + perm32(R & 31)) : R;
        voA[i] = (unsigned)(R * pitchB + C * 2); voA[2 + i] = voA[i] + (unsigned)hstep; voffB[i] = (unsigned)(Rb * pitchB + C * 2); }
    const unsigned ldsw = (unsigned)wid * 1024u;
    const int aoffk[2] = {lds_byte(wr * 64 + fr, fq * 8), lds_byte(wr * 64 + fr, 32 + fq * 8)}, boffk[2] = {lds_byte(wc * 32 + fr, fq * 8), lds_byte(wc * 32 + fr, 32 + fq * 8)};
#define PG8_SA(b, h) (((b) * 2 + (h)) * HTB)
#define PG8_SB(b, h) ((4 + (b) * 2 + (h)) * HTB)
#define PG8_STAGE2(bufoff, gbase, o0, o1) do { \
        __builtin_amdgcn_global_load_lds((const unsigned*)((const char*)(gbase) + (o0)), (LAS unsigned*)(lds + (bufoff) + ldsw), 16, 0, 0); \
        __builtin_amdgcn_global_load_lds((const unsigned*)((const char*)(gbase) + (o1)), (LAS unsigned*)(lds + (bufoff) + ldsw + 8192), 16, 0, 0); } while (0)
#define PG8_STAGEB(bufoff, gbase) PG8_STAGE2(bufoff, gbase, voffB[0], voffB[1])
#ifndef PROBE_LDS2
#define PROBE_LDS2 0
#endif
#ifndef PROBE_EPI
#define PROBE_EPI 0
#endif
#define PG8_LDA1(dst, b, h) do { _Pragma("unroll") for (int m = 0; m < 4; ++m) _Pragma("unroll") for (int k = 0; k < 2; ++k) dst[m][k] = *(const LAS bf16x8*)(lds + PG8_SA(b, h) + aoffk[k] + m * 2048); } while (0)
#define PG8_LDA(dst, b, h) do { if (PROBE_LDS2) { _Pragma("unroll") for (int m = 0; m < 4; ++m) _Pragma("unroll") for (int k = 0; k < 2; ++k) { bf16x8 t_ = *(const LAS bf16x8*)(lds + PG8_SA(b, h) + aoffk[k] + m * 2048); asm volatile("" :: "v"(t_)); } asm volatile("" ::: "memory"); } PG8_LDA1(dst, b, h); } while (0)
#define PG8_LDB1(dst, b, h) do { _Pragma("unroll") for (int n = 0; n < 2; ++n) _Pragma("unroll") for (int k = 0; k < 2; ++k) dst[n][k] = *(const LAS bf16x8*)(lds + PG8_SB(b, h) + boffk[k] + n * 2048); } while (0)
#define PG8_LDB(dst, b, h) do { if (PROBE_LDS2) { _Pragma("unroll") for (int n = 0; n < 2; ++n) _Pragma("unroll") for (int k = 0; k < 2; ++k) { bf16x8 t_ = *(const LAS bf16x8*)(lds + PG8_SB(b, h) + boffk[k] + n * 2048); asm volatile("" :: "v"(t_)); } asm volatile("" ::: "memory"); } PG8_LDB1(dst, b, h); } while (0)
#define PG8_MMA(ai, bj, At, Bt) do { __builtin_amdgcn_s_setprio(1); _Pragma("unroll") for (int m = 0; m < 4; ++m) _Pragma("unroll") for (int n = 0; n < 2; ++n) { \
        if constexpr (FP8) { const i32x8 b8_ = cat16(Bt[n][0], Bt[n][1]), a8_ = cat16(At[m][0], At[m][1]); \
            asm volatile("v_mfma_scale_f32_16x16x128_f8f6f4 %0, %1, %2, %0, %3, %3 op_sel_hi:[0,0,0]" : "+v"(acc[ai][bj][m][n]) : "v"(b8_), "v"(a8_), "v"(one_scale)); } \
        else { _Pragma("unroll") for (int k = 0; k < 2; ++k) acc[ai][bj][m][n] = __builtin_amdgcn_mfma_f32_16x16x32_bf16(Bt[n][k], At[m][k], acc[ai][bj][m][n], 0, 0, 0); } } \
        __builtin_amdgcn_s_setprio(0); } while (0)
#define PG8_WAIT_V(n) asm volatile("s_waitcnt vmcnt(" #n ")" ::: "memory")
#define PG8_WAIT_L(n) asm volatile("s_waitcnt lgkmcnt(" #n ")" ::: "memory")
#define PG8_BAR __builtin_amdgcn_s_barrier()
#define PG8_SCHED __builtin_amdgcn_sched_barrier(0)
    Unit cur, nxt; int ui = 0;
    if (!S.next(0, cur)) return;
    const unsigned one_scale = 0x7F7F7F7Fu;
    f32x4 acc[2][2][4][2];
#pragma unroll
    for (int a = 0; a < 2; ++a)
#pragma unroll
        for (int b = 0; b < 2; ++b)
#pragma unroll
            for (int m = 0; m < 4; ++m)
#pragma unroll
                for (int n = 0; n < 2; ++n) acc[a][b][m][n] = (f32x4){0.f, 0.f, 0.f, 0.f};
    bf16x8 At[4][2], B0[2][2], B1[2][2];
    const char* cA = S.a_base(cur); const char* cB = S.b_base(cur);
    unsigned voN[4];
    if constexpr (GATHER) { S.a_off(cur, tid, voA); }
#pragma unroll
    for (int i = 0; i < 4; ++i) voN[i] = voA[i];
    if constexpr (SP2) {
        PG8_STAGEB(PG8_SB(0, 0), cB); PG8_STAGEB(PG8_SB(0, 1), cB + hstep); PG8_STAGE2(PG8_SA(0, 0), cA, voA[0], voA[1]); PG8_STAGE2(PG8_SA(0, 1), cA, voA[2], voA[3]);
        if (wr == 1) PG8_BAR;
        PG8_WAIT_V(2); PG8_BAR;
        PG8_STAGEB(PG8_SB(1, 0), cB + kstep); PG8_STAGE2(PG8_SA(1, 0), cA + kstep, voA[0], voA[1]); PG8_STAGEB(PG8_SB(1, 1), cB + hstep + kstep);
        PG8_WAIT_V(6); PG8_BAR;
    } else {
        PG8_STAGEB(PG8_SB(0, 0), cB); PG8_STAGE2(PG8_SA(0, 0), cA, voA[0], voA[1]); PG8_STAGEB(PG8_SB(0, 1), cB + hstep); PG8_STAGE2(PG8_SA(0, 1), cA, voA[2], voA[3]);
        if (wr == 1) PG8_BAR;
        PG8_WAIT_V(4); PG8_BAR;
        PG8_STAGEB(PG8_SB(1, 0), cB + kstep); PG8_STAGE2(PG8_SA(1, 0), cA + kstep, voA[0], voA[1]); PG8_STAGEB(PG8_SB(1, 1), cB + hstep + kstep);
        PG8_WAIT_V(6); PG8_BAR;
    }
    for (;;) {
        const bool has_next = S.next(ui + 1, nxt);
        const bool skip1 = S.skip_hi(cur);
        const char* nA = has_next ? S.a_base(nxt) : cA; const char* nB = has_next ? S.b_base(nxt) : cB;
        for (int t = 0; t < nt; t += 2) {
            const bool last = (t == nt - 2);
            const char* a1 = cA + (size_t)(t + 1) * kstep;
            const char* a2 = last ? nA : cA + (size_t)(t + 2) * kstep; const char* b2 = last ? nB : cB + (size_t)(t + 2) * kstep;
            const char* a3 = a2 + kstep; const char* b3 = b2 + kstep;
            unsigned v2[4];
            if constexpr (GATHER) {
                if (t == nt - 4 && has_next) S.a_tok_dma(nxt, lds, wid, lane);
                if (last && has_next) S.a_off_lds(lds, tid, voN);
#pragma unroll
                for (int i = 0; i < 4; ++i) v2[i] = last ? voN[i] : voA[i];
            } else {
#pragma unroll
                for (int i = 0; i < 4; ++i) v2[i] = voA[i];
            }
            if (last) E.prefetch(cur, lds, wid, lane);
            if constexpr (SP2) {
            PG8_LDB(B0, 0, 0); PG8_LDB(B1, 0, 1); PG8_SCHED; PG8_LDA(At, 0, 0); PG8_STAGE2(PG8_SA(1, 1), a1, voA[2], voA[3]);
            PG8_WAIT_V(8); PG8_WAIT_L(0); PG8_BAR; PG8_MMA(0, 0, At, B0); PG8_MMA(0, 1, At, B1); PG8_BAR; PG8_SCHED;
            PG8_LDA(At, 0, 1); PG8_STAGEB(PG8_SB(0, 0), b2); PG8_STAGEB(PG8_SB(0, 1), b2 + hstep); PG8_STAGE2(PG8_SA(0, 0), a2, v2[0], v2[1]);
            PG8_WAIT_V(8); PG8_WAIT_L(0); PG8_BAR; if (!skip1) { PG8_MMA(1, 0, At, B0); PG8_MMA(1, 1, At, B1); } PG8_BAR; PG8_SCHED;
            PG8_LDB(B0, 1, 0); PG8_LDB(B1, 1, 1); PG8_SCHED; PG8_LDA(At, 1, 0); PG8_STAGE2(PG8_SA(0, 1), a2, v2[2], v2[3]);
            PG8_WAIT_V(8); PG8_WAIT_L(0); PG8_BAR; PG8_MMA(0, 0, At, B0); PG8_MMA(0, 1, At, B1); PG8_BAR; PG8_SCHED;
            PG8_LDA(At, 1, 1); PG8_STAGEB(PG8_SB(1, 0), b3); PG8_STAGEB(PG8_SB(1, 1), b3 + hstep); PG8_STAGE2(PG8_SA(1, 0), a3, v2[0], v2[1]);
            PG8_WAIT_V(8); PG8_WAIT_L(0); PG8_BAR; if (!skip1) { PG8_MMA(1, 0, At, B0); PG8_MMA(1, 1, At, B1); } PG8_BAR; PG8_SCHED;
            } else {
            PG8_LDB(B0, 0, 0); PG8_SCHED; PG8_LDA(At, 0, 0); PG8_STAGE2(PG8_SA(1, 1), a1, voA[2], voA[3]);
            PG8_WAIT_L(8); PG8_BAR; PG8_WAIT_L(0); PG8_MMA(0, 0, At, B0); PG8_BAR; PG8_SCHED;
            PG8_LDB(B1, 0, 1); PG8_STAGEB(PG8_SB(0, 0), b2);
            PG8_BAR; PG8_WAIT_L(0); PG8_MMA(0, 1, At, B1); PG8_BAR;
            PG8_LDA(At, 0, 1); PG8_STAGE2(PG8_SA(0, 0), a2, v2[0], v2[1]);
            PG8_BAR; PG8_WAIT_L(0); PG8_MMA(1, 0, At, B0); PG8_BAR; PG8_SCHED;
            PG8_STAGEB(PG8_SB(0, 1), b2 + hstep);
            PG8_WAIT_V(6); PG8_BAR; PG8_MMA(1, 1, At, B1); PG8_BAR;
            PG8_LDB(B0, 1, 0); PG8_SCHED; PG8_LDA(At, 1, 0); PG8_STAGE2(PG8_SA(0, 1), a2, v2[2], v2[3]);
            PG8_WAIT_L(8); PG8_BAR; PG8_WAIT_L(0); PG8_MMA(0, 0, At, B0); PG8_BAR; PG8_SCHED;
            PG8_LDB(B1, 1, 1); PG8_STAGEB(PG8_SB(1, 0), b3);
            PG8_BAR; PG8_WAIT_L(0); PG8_MMA(0, 1, At, B1); PG8_BAR;
            PG8_LDA(At, 1, 1); PG8_STAGE2(PG8_SA(1, 0), a3, v2[0], v2[1]);
            PG8_BAR; PG8_WAIT_L(0); PG8_MMA(1, 0, At, B0); PG8_BAR; PG8_SCHED;
            PG8_STAGEB(PG8_SB(1, 1), b3 + hstep);
            PG8_WAIT_V(6); PG8_BAR; PG8_MMA(1, 1, At, B1); PG8_BAR;
            }
        }
        if constexpr (ALIGN_EPI) { if (wr == 0) PG8_BAR; }
        if constexpr (FP8) asm volatile("s_nop 15\n\ts_nop 15" ::: "memory");
        E(acc, cur, wr, wc, fr, fq);
        if (PROBE_EPI & Epi::ID) { asm volatile("" ::: "memory"); E(acc, cur, wr, wc, fr, fq); }
        if (!has_next) break;
#pragma unroll
        for (int a = 0; a < 2; ++a)
#pragma unroll
            for (int b = 0; b < 2; ++b)
#pragma unroll
                for (int m = 0; m < 4; ++m)
#pragma unroll
                    for (int n = 0; n < 2; ++n) acc[a][b][m][n] = (f32x4){0.f, 0.f, 0.f, 0.f};
        if constexpr (FP8) asm volatile("s_nop 4" ::: "memory");
        cur = nxt; cA = nA; cB = nB; ++ui;
        if constexpr (ALIGN_EPI) { if (wr == 1) PG8_BAR; }
        if constexpr (GATHER) {
#pragma unroll
            for (int i = 0; i < 4; ++i) voA[i] = voN[i];
        }
    }
    PG8_WAIT_V(0);
    if constexpr (!ALIGN_EPI) { if (wr == 0) PG8_BAR; }
    PG8_BAR;
#undef PG8_SA
#undef PG8_SB
#undef PG8_STAGE2
#undef PG8_STAGEB
#undef PG8_LDA
#undef PG8_LDB
#undef PG8_LDA1
#undef PG8_LDB1
#undef PG8_MMA
#undef PG8_WAIT_V
#undef PG8_WAIT_L
#undef PG8_BAR
#undef PG8_SCHED
}
}

struct Frame {
    LAS unsigned char* lds;
    volatile LAS unsigned* MISC;
    gu32* ctl;
    int tid, wave, vcu, G;
    const float* in[22];
    float* out;
    unsigned char* ws;
};
#define IN_X 0
#define IN_META 1
#define IN_ANG 2
#define IN_WIN 3
#define IN_DECF 4
#define IN_DECB 5
#define IN_RETG 6
#define IN_QG 7
#define IN_KG 8
#define IN_LQ1 9
#define IN_LK1 10
#define IN_LQ2 11
#define IN_LK2 12
#define IN_DOG 13
#define IN_WOUT 14
#define IN_FNG 15
#define IN_WR 16
#define IN_BR 17
#define IN_WGU 18
#define IN_BGU 19
#define IN_WD 20
#define IN_BD 21

__device__ __forceinline__ void p0_transpose_item(const float* W, int K, int N, bf16* WT, int row_off, LAS float* scr, int kb, int nb, int lane) {
    const int k0 = 64 * kb, n0 = 32 * nb;
#pragma unroll 8
    for (int i = 0; i < 32; ++i) { const int kk = 2 * i + (lane >> 5); scr[kk * 33 + (lane & 31)] = W[(size_t)(k0 + kk) * N + n0 + (lane & 31)]; }
    LDS_WAIT(); asm volatile("" ::: "memory");
    const int c = lane & 7;
#pragma unroll
    for (int j = 0; j < 4; ++j) { const int n = (lane >> 3) + 8 * j; const LAS float* s = scr + (8 * c) * 33 + n;
        v4u o; o.x = pk2(s[0 * 33], s[1 * 33]); o.y = pk2(s[2 * 33], s[3 * 33]); o.z = pk2(s[4 * 33], s[5 * 33]); o.w = pk2(s[6 * 33], s[7 * 33]);
        *(GAS v4u*)(WT + (size_t)(row_off + n0 + n) * K + k0 + 8 * c) = o; }
    LDS_WAIT(); asm volatile("" ::: "memory");
}
__device__ __forceinline__ void p0_transpose_item_fp8(const float* W, int K, int N, unsigned char* WT, int row_off, LAS unsigned* tl, int kb, int nb, int lane, float sc) {
    const int k0 = 128 * kb, n0 = 64 * nb, n4 = lane & 15, kq = lane >> 4;
    const float* src = W + (size_t)(k0 + 4 * kq) * N + n0 + 4 * n4;
#pragma unroll
    for (int half = 0; half < 2; ++half) {
        f32x4 v[4][4];
#pragma unroll
        for (int g = 0; g < 4; ++g)
#pragma unroll
            for (int e = 0; e < 4; ++e) v[g][e] = __builtin_nontemporal_load((const GAS f32x4*)(src + (size_t)(16 * (4 * half + g) + e) * N));
#pragma unroll
        for (int g = 0; g < 4; ++g)
#pragma unroll
            for (int c = 0; c < 4; ++c) tl[(4 * n4 + c) * 33 + 4 * (4 * half + g) + kq] = pk4_fp8(v[g][0][c] * sc, v[g][1][c] * sc, v[g][2][c] * sc, v[g][3][c] * sc);
    }
    LDS_WAIT(); asm volatile("" ::: "memory");
    const int ch = lane & 7;
#pragma unroll
    for (int j = 0; j < 8; ++j) { const int n = (lane >> 3) + 8 * j; const LAS unsigned* t = tl + n * 33 + 4 * ch;
        v4u o; o.x = t[0]; o.y = t[1]; o.z = t[2]; o.w = t[3];
        __builtin_nontemporal_store(o, (GAS v4u*)(WT + (size_t)(row_off + n0 + n) * K + k0 + 16 * ch)); }
    LDS_WAIT(); asm volatile("" ::: "memory");
}
__device__ __forceinline__ void rms_row_to_bf16(int lane, const float* xrow, const float* gain, bf16* orow) {
    const GAS f32x4* xr = (const GAS f32x4*)xrow + lane;
    const GAS f32x4* gr = (const GAS f32x4*)gain + lane;
    f32x4 v[8]; float s = 0.f;
#pragma unroll
    for (int j = 0; j < 8; ++j) { v[j] = xr[64 * j]; s += (v[j].x * v[j].x + v[j].y * v[j].y) + (v[j].z * v[j].z + v[j].w * v[j].w); }
    const float rstd = 1.f / sqrtf(wave_sum(s) * (1.f / DM) + EPS);
    GAS v2u* o8 = (GAS v2u*)orow + lane;
#pragma unroll
    for (int j = 0; j < 8; ++j) { const f32x4 g = gr[64 * j]; v2u w; w.x = pk2(v[j].x * rstd * g.x, v[j].y * rstd * g.y); w.y = pk2(v[j].z * rstd * g.z, v[j].w * rstd * g.w); o8[64 * j] = w; }
}
__device__ __forceinline__ void p0_prologue(Frame& F) {
    LAS float* scr = (LAS float*)(F.lds + F.wave * 19456);
    const int gw = F.vcu * NWAVES + F.wave, NGW = F.G * NWAVES;
    bf16* WIN_T = (bf16*)(F.ws + WS_WIN); bf16* WOUT_T = (bf16*)(F.ws + WS_WOUT);
    constexpr int I_IN = 32 * (NIN / 32), I_OUT = 32 * (DM / 32);
    for (int it = gw; it < I_IN + I_OUT; it += NGW) {
        int r = it;
        if (r < I_IN) { const int nbk = NIN / 32; p0_transpose_item(F.in[IN_WIN], DM, NIN, WIN_T, 0, scr, r / nbk, r % nbk, lane_id()); continue; } r -= I_IN;
        { const int nbk = DM / 32; p0_transpose_item(F.in[IN_WOUT], DM, DM, WOUT_T, 0, scr, r / nbk, r % nbk, lane_id()); }
    }
    bf16* U = (bf16*)(F.ws + WS_U);
    for (int m = gw; m < T + NMETA; m += NGW) {
        if (m < T) rms_row_to_bf16(lane_id(), F.in[IN_X] + (size_t)m * DM, F.in[IN_ANG], U + (size_t)m * DM);
        else rms_row_to_bf16(lane_id(), F.in[IN_META] + (size_t)(m - T) * DM, F.in[IN_ANG], U + (size_t)m * DM);
    }
    { bf16* Z = (bf16*)(F.ws + WS_Z);
      for (int m = T + NMETA + gw; m < T + 128; m += NGW) { GAS v4u* o = (GAS v4u*)(Z + (size_t)m * NIN) + lane_id();
#pragma unroll
          for (int j = 0; j < 12; ++j) o[64 * j] = (v4u){0u, 0u, 0u, 0u}; } }
}
__device__ __forceinline__ void p0_expert_item(Frame& F, int it) {
    LAS float* scr = (LAS float*)(F.lds + F.wave * 19456);
#if MOE_FP8
    constexpr int KB_E = 16;
    unsigned char* WGU_T = F.ws + WS_WGU; unsigned char* WD_T = F.ws + WS_WD;
#else
    constexpr int KB_E = 32;
    bf16* WGU_T = (bf16*)(F.ws + WS_WGU); bf16* WD_T = (bf16*)(F.ws + WS_WD);
#endif
    constexpr int NBW = MOE_FP8 ? 64 : 32;
    constexpr int I_GU = KB_E * (4096 / NBW), I_D = KB_E * (DM / NBW);
    constexpr int NITEMS = NE * I_GU + NE * I_D;
        int r = it;
        if (r < NE * I_GU) { const int e = r / I_GU, q = r % I_GU, nbk = 4096 / NBW, kb = q / nbk, nb = q % nbk, n0 = NBW * nb;
            const int j = n0 & 2047, isup = n0 >> 11, dest = (j >> 7) * 256 + isup * 128 + (j & 127);
#if MOE_FP8
            p0_transpose_item_fp8(F.in[IN_WGU] + (size_t)e * DM * 4096, DM, 4096, WGU_T + (size_t)e * 4096 * DM, dest - n0, (LAS unsigned*)scr, kb, nb, lane_id(), FP8_SW); return; } r -= NE * I_GU;
#else
            p0_transpose_item(F.in[IN_WGU] + (size_t)e * DM * 4096, DM, 4096, WGU_T + (size_t)e * 4096 * DM, dest - n0, scr, kb, nb, lane_id()); return; } r -= NE * I_GU;
#endif
        { const int e = r / I_D, q = r % I_D, nbk = DM / NBW;
#if MOE_FP8
            p0_transpose_item_fp8(F.in[IN_WD] + (size_t)e * DFF * DM, DFF, DM, WD_T + (size_t)e * DM * DFF, 0, (LAS unsigned*)scr, q / nbk, q % nbk, lane_id(), FP8_SW); }
#else
            p0_transpose_item(F.in[IN_WD] + (size_t)e * DFF * DM, DFF, DM, WD_T + (size_t)e * DM * DFF, 0, scr, q / nbk, q % nbk, lane_id()); }
#endif

}
constexpr int CONV_ITEMS = NE * ((MOE_FP8 ? 16 : 32) * (4096 / (MOE_FP8 ? 64 : 32))) + NE * ((MOE_FP8 ? 16 : 32) * (DM / (MOE_FP8 ? 64 : 32))), CONV_TICKETS = CONV_ITEMS / NWAVES;
__device__ __forceinline__ void p0_experts_q(Frame& F, int cw, int first, int last) {
    for (;;) {
        __syncthreads();
        if (F.tid == 0) F.MISC[22] = __hip_atomic_fetch_add(F.ctl + cw, 1u, __ATOMIC_RELAXED, __HIP_MEMORY_SCOPE_AGENT);
        __syncthreads();
        const int t = first + __builtin_amdgcn_readfirstlane((int)F.MISC[22]);
        if (t >= last) break;
        p0_expert_item(F, t * NWAVES + F.wave);
    }
    __syncthreads();
}
__device__ __forceinline__ void p1_meta_rows(Frame& F) {
    int lane = lane_id(); asm volatile("" : "+v"(lane));
    const int gw = F.vcu * NWAVES + F.wave;
    if (gw >= 224) return;
    const bf16* U = (const bf16*)(F.ws + WS_U); const bf16* W = (const bf16*)(F.ws + WS_WIN); bf16* Z = (bf16*)(F.ws + WS_Z);
    const int col0 = gw < 32 ? C_RK + 16 * gw : gw < 96 ? C_RV + 16 * (gw - 32) : C_DK + 16 * (gw - 96);
    const bf16* ap = U + (size_t)(T + (lane & 15)) * DM + 8 * (lane >> 4);
    const bf16* bp = W + (size_t)(col0 + (lane & 15)) * DM + 8 * (lane >> 4);
    f32x4 acc = (f32x4){0.f, 0.f, 0.f, 0.f};
#pragma unroll 8
    for (int st = 0; st < DM / 32; ++st) { const bf16x8 a = *(const GAS bf16x8*)(ap + 32 * st), b = *(const GAS bf16x8*)(bp + 32 * st);
        acc = __builtin_amdgcn_mfma_f32_16x16x32_bf16(a, b, acc, 0, 0, 0); }
    const float sc = gw < 32 ? 0.08838834764831845f : 1.f;
#pragma unroll
    for (int r = 0; r < 4; ++r) Z[(size_t)(T + 4 * (lane >> 4) + r) * NIN + col0 + (lane & 15)] = (bf16)f2bf(acc[r] * sc);
}

struct DenseSched {
    const bf16* A; const bf16* Bt; int nM, nN, pitch, G, c;
    __device__ __forceinline__ bool next(int i, pg8::Unit& u) const { u.e = 0; return pg8::order_next(i, G, c, nM, nN, u.pm, u.pn); }
    __device__ __forceinline__ const char* a_base(const pg8::Unit& u) const { return (const char*)A + (size_t)u.pm * 256 * pitch; }
    __device__ __forceinline__ const char* b_base(const pg8::Unit& u) const { return (const char*)Bt + (size_t)u.pn * 256 * pitch; }
    __device__ __forceinline__ void a_off(const pg8::Unit&, int, unsigned (&)[4]) const {}
    __device__ __forceinline__ bool skip_hi(const pg8::Unit&) const { return false; }
    __device__ __forceinline__ void a_tok_dma(const pg8::Unit&, LAS unsigned char*, int, int) const {}
    __device__ __forceinline__ void a_off_lds(LAS unsigned char*, int, unsigned (&)[4]) const {}
};
struct QueueSched {
    const bf16* A; const bf16* Bt; int nQ, nN, pitch, q0; gu32* cnt; volatile LAS int* slot;
    __device__ __forceinline__ bool next(int i, pg8::Unit& u) const {
        const int per_q = 8 * nN;
        if (threadIdx.x == 0) { int L = -1;
            for (int k = 0; k < nQ; ++k) { const int q = (q0 + k) % nQ; const unsigned t = __hip_atomic_fetch_add(cnt + 64 * q, 1u, __ATOMIC_RELAXED, __HIP_MEMORY_SCOPE_AGENT);
                if (t < (unsigned)per_q) { L = q * per_q + (int)t; break; } }
            slot[i & 1] = L; }
        asm volatile("s_waitcnt lgkmcnt(0)" ::: "memory"); __builtin_amdgcn_s_barrier(); asm volatile("" ::: "memory");
        const int L = __builtin_amdgcn_readfirstlane(slot[i & 1]);
        if (L < 0) return false;
        const int q = L / per_q, t = L % per_q; u.pm = 8 * q + (t & 7); u.pn = t >> 3; u.e = 0; return true; }
    __device__ __forceinline__ const char* a_base(const pg8::Unit& u) const { return (const char*)A + (size_t)u.pm * 256 * pitch; }
    __device__ __forceinline__ const char* b_base(const pg8::Unit& u) const { return (const char*)Bt + (size_t)u.pn * 256 * pitch; }
    __device__ __forceinline__ void a_off(const pg8::Unit&, int, unsigned (&)[4]) const {}
    __device__ __forceinline__ bool skip_hi(const pg8::Unit&) const { return false; }
    __device__ __forceinline__ void a_tok_dma(const pg8::Unit&, LAS unsigned char*, int, int) const {}
    __device__ __forceinline__ void a_off_lds(LAS unsigned char*, int, unsigned (&)[4]) const {}
};
struct EpiZ {
    static constexpr bool PERM = true; static constexpr int ID = 1;
    bf16* Z; const float* qg; const float* kg; LAS float* P;
    __device__ __forceinline__ void prefetch(const pg8::Unit&, LAS unsigned char*, int, int) const {}
    __device__ __forceinline__ void operator()(const f32x4 (&acc)[2][2][4][2], const pg8::Unit& u, int wr, int wc, int fr, int fq) const {
        const int row0 = u.pm * 256 + wr * 64 + fr, col0 = u.pn * 256 + wc * 32 + 8 * fq;
        if (u.pn >= 12 && u.pn < 20) {
            const float* gp = (u.pn < 16 ? qg : kg) + wc * 32 + 8 * fq; const float gs = u.pn < 16 ? 0.08838834764831845f : 1.f;
            const f32x4 g0 = *(const f32x4*)gp * gs, g1 = *(const f32x4*)(gp + 4) * gs;
#pragma unroll
            for (int ai = 0; ai < 2; ++ai)
#pragma unroll
                for (int m = 0; m < 4; ++m)
#pragma unroll
                    for (int bj = 0; bj < 2; ++bj) { const f32x4 a = acc[ai][bj][m][0], b = acc[ai][bj][m][1];
                        float sq = (a[0] * a[0] + a[1] * a[1]) + (a[2] * a[2] + a[3] * a[3]) + (b[0] * b[0] + b[1] * b[1]) + (b[2] * b[2] + b[3] * b[3]);
                        sq = red_x32(red_x16(sq));
                        if (fq == 0) P[(ai * 128 + wr * 64 + m * 16 + fr) * 8 + bj * 4 + wc] = sq; }
            asm volatile("s_waitcnt lgkmcnt(0)" ::: "memory"); __builtin_amdgcn_s_barrier(); asm volatile("" ::: "memory");
#pragma unroll
            for (int ai = 0; ai < 2; ++ai)
#pragma unroll
                for (int m = 0; m < 4; ++m) { bf16* rowp = Z + (size_t)(row0 + ai * 128 + m * 16) * NIN + col0;
#pragma unroll
                    for (int bj = 0; bj < 2; ++bj) { const f32x4 pp = *(const LAS f32x4*)(P + (ai * 128 + wr * 64 + m * 16 + fr) * 8 + bj * 4);
                        const float rstd = __builtin_amdgcn_rsqf(((pp[0] + pp[1]) + (pp[2] + pp[3])) * (1.f / 128.f) + EPS);
                        const f32x4 v0 = acc[ai][bj][m][0] * g0 * rstd, v1 = acc[ai][bj][m][1] * g1 * rstd;
                        v4u w; w.x = cvtpk(v0[0], v0[1]); w.y = cvtpk(v0[2], v0[3]); w.z = cvtpk(v1[0], v1[1]); w.w = cvtpk(v1[2], v1[3]);
                        *(v4u*)(rowp + bj * 128) = w; } }
            return;
        }
        const float s = (u.pn == 2 || u.pn == 3) ? 0.08838834764831845f : 1.f;
#pragma unroll
        for (int ai = 0; ai < 2; ++ai)
#pragma unroll
            for (int m = 0; m < 4; ++m) { bf16* rowp = Z + (size_t)(row0 + ai * 128 + m * 16) * NIN + col0;
#pragma unroll
                for (int bj = 0; bj < 2; ++bj) { const f32x4 v0 = acc[ai][bj][m][0] * s, v1 = acc[ai][bj][m][1] * s;
                    v4u w; w.x = cvtpk(v0[0], v0[1]); w.y = cvtpk(v0[2], v0[3]); w.z = cvtpk(v1[0], v1[1]); w.w = cvtpk(v1[2], v1[3]);
                    *(v4u*)(rowp + bj * 128) = w; } }
    }
};
struct EpiOut {
    static constexpr bool PERM = true; static constexpr int ID = 2;
    const float* X; bf16* H;
    __device__ __forceinline__ void prefetch(const pg8::Unit&, LAS unsigned char*, int, int) const {}
    __device__ __forceinline__ void operator()(const f32x4 (&acc)[2][2][4][2], const pg8::Unit& u, int wr, int wc, int fr, int fq) const {
        const int row0 = u.pm * 256 + wr * 64 + fr, col0 = u.pn * 256 + wc * 32 + 8 * fq;
#pragma unroll
        for (int ai = 0; ai < 2; ++ai) {
            f32x4 xv[4][2][2];
#pragma unroll
            for (int m = 0; m < 4; ++m) { const size_t off = (size_t)(row0 + ai * 128 + m * 16) * DM + col0;
#pragma unroll
                for (int bj = 0; bj < 2; ++bj)
#pragma unroll
                    for (int n = 0; n < 2; ++n) xv[m][bj][n] = *(const f32x4*)(X + off + bj * 128 + n * 4); }
            asm volatile("" ::: "memory");
#pragma unroll
            for (int m = 0; m < 4; ++m) { const size_t off = (size_t)(row0 + ai * 128 + m * 16) * DM + col0;
#pragma unroll
                for (int bj = 0; bj < 2; ++bj) { const f32x4 v0 = acc[ai][bj][m][0] + xv[m][bj][0], v1 = acc[ai][bj][m][1] + xv[m][bj][1];
                    v4u w; w.x = cvtpk(v0[0], v0[1]); w.y = cvtpk(v0[2], v0[3]); w.z = cvtpk(v1[0], v1[1]); w.w = cvtpk(v1[2], v1[3]);
                    *(v4u*)(H + off + bj * 128) = w; } }
            asm volatile("" ::: "memory"); }
    }
};
struct MoeTab { LAS int* cnt; LAS int* rbase; LAS int* tile_e; LAS int* tile_r0; LAS int* ntiles; };
__device__ __forceinline__ MoeTab moe_tab(Frame& F) {
    MoeTab t; LAS int* p = (LAS int*)(F.lds + TAB_OFF);
    t.cnt = p; t.rbase = p + 32; t.ntiles = p + 64; t.tile_e = p + 128; t.tile_r0 = p + 128 + 320; return t;
}
__device__ __forceinline__ void moe_build_tables(Frame& F) {
    MoeTab t = moe_tab(F);
    __syncthreads();
    if (F.tid < NE) { int c = (int)__hip_atomic_load(F.ctl + CW_CNT + 64 * F.tid, __ATOMIC_RELAXED, __HIP_MEMORY_SCOPE_AGENT); if (c > ECAP) c = ECAP; if (c < 0) c = 0; t.cnt[F.tid] = c; }
    __syncthreads();
    if (F.tid == 0) {
        int nt = 0;
        for (int e = 0; e < NE; ++e) { const int c = t.cnt[e], k = (c + 255) >> 8; t.rbase[e] = nt * 256;
            for (int j = 0; j < k; ++j) { t.tile_e[nt + j] = e; t.tile_r0[nt + j] = j * 256; }
            nt += k; }
        t.ntiles[0] = nt;
    }
    __syncthreads();
}
struct MoeSched {
    const unsigned char* A; const unsigned char* Wt; size_t wstride_bytes; int nN, pitch, G, c; MoeTab tb; const int* tok;
    __device__ __forceinline__ bool next(int i, pg8::Unit& u) const {
        const int nM = tb.ntiles[0]; int pm, pn; if (!pg8::order_next(i, G, c, nM, nN, pm, pn)) return false;
        u.pm = pm; u.pn = pn; u.e = __builtin_amdgcn_readfirstlane(tb.tile_e[pm]); return true; }
    __device__ __forceinline__ const char* a_base(const pg8::Unit& u) const { return tok ? (const char*)A : (const char*)A + (size_t)u.pm * 256 * pitch; }
    __device__ __forceinline__ const char* b_base(const pg8::Unit& u) const { return (const char*)Wt + (size_t)u.e * wstride_bytes + (size_t)u.pn * 256 * pitch; }
    __device__ __forceinline__ bool skip_hi(const pg8::Unit& u) const { return __builtin_amdgcn_readfirstlane(tb.cnt[u.e] - tb.tile_r0[u.pm]) <= 128; }
    __device__ __forceinline__ void a_tok(const pg8::Unit& u, int tid, int (&tk)[4]) const {
        const int r0 = tb.tile_r0[u.pm], cn = tb.cnt[u.e];
#pragma unroll
        for (int i = 0; i < 2; ++i) { int R, C; pg8::stage_rc(tid * 16 + i * 8192, R, C);
#pragma unroll
            for (int h = 0; h < 2; ++h) { const int rl = r0 + h * 128 + R; tk[2 * h + i] = tok[(size_t)u.e * ECAP + (rl < cn ? rl : 0)] * (rl < cn ? 1 : 0); } }
    }
    __device__ __forceinline__ void a_off_tok(const int (&tk)[4], int tid, unsigned (&vo)[4]) const {
#pragma unroll
        for (int i = 0; i < 2; ++i) { int R, C; pg8::stage_rc(tid * 16 + i * 8192, R, C);
#pragma unroll
            for (int h = 0; h < 2; ++h) vo[2 * h + i] = (unsigned)tk[2 * h + i] * (unsigned)pitch + (unsigned)C * 2u; }
    }
    __device__ __forceinline__ void a_off(const pg8::Unit& u, int tid, unsigned (&vo)[4]) const { int tk[4]; a_tok(u, tid, tk); a_off_tok(tk, tid, vo); }
    __device__ __forceinline__ void a_tok_dma(const pg8::Unit& u, LAS unsigned char* lds, int wid, int lane) const {
        if (wid < 4) { const int rl = tb.tile_r0[u.pm] + wid * 64 + lane;
            __builtin_amdgcn_global_load_lds((const unsigned*)(tok + (size_t)u.e * ECAP + (rl < tb.cnt[u.e] ? rl : 0)), (LAS unsigned*)(lds + EPF_OFF + 2048) + wid * 64, 4, 0, 0); }
    }
    __device__ __forceinline__ void a_off_lds(LAS unsigned char* lds, int tid, unsigned (&vo)[4]) const {
        const LAS int* TK = (const LAS int*)(lds + EPF_OFF + 2048);
#pragma unroll
        for (int i = 0; i < 2; ++i) { int R, C; pg8::stage_rc(tid * 16 + i * 8192, R, C);
#pragma unroll
            for (int h = 0; h < 2; ++h) vo[2 * h + i] = (unsigned)TK[h * 128 + R] * (unsigned)pitch + (unsigned)C * 2u; }
    }
};
struct EpiAct {
    static constexpr bool PERM = true; static constexpr int ID = 4;
    unsigned char* ACT; const float* bgu; const float* rs; MoeTab tb; LAS unsigned char* lds;
    __device__ __forceinline__ void prefetch(const pg8::Unit& u, LAS unsigned char* lds, int wid, int lane) const {
        LAS unsigned* P = (LAS unsigned*)(lds + EPF_OFF) + wid * 64;
        const float* src;
        if (wid < 4) { const int rl = tb.tile_r0[u.pm] + wid * 64 + lane; src = rs + (size_t)u.e * ECAP + (rl < tb.cnt[u.e] ? rl : 0); }
        else { const int idx = (wid - 4) * 64 + lane; src = bgu + (size_t)u.e * 4096 + u.pn * 128 + (idx & 127) + (idx >> 7) * 2048; }
        __builtin_amdgcn_global_load_lds((const unsigned*)src, P, 4, 0, 0);
    }
    __device__ __forceinline__ void operator()(const f32x4 (&acc)[2][2][4][2], const pg8::Unit& u, int wr, int wc, int fr, int fq) const {
        const int lrow0 = wr * 64 + fr, col0 = u.pn * 128 + wc * 32 + 8 * fq;
        const int r0 = tb.tile_r0[u.pm], cn = tb.cnt[u.e];
        const LAS float* PF = (const LAS float*)(lds + EPF_OFF);
        const LAS float* bg = PF + 256 + wc * 32 + 8 * fq;
        const f32x4 g0 = *(const LAS f32x4*)bg, g1 = *(const LAS f32x4*)(bg + 4), u0 = *(const LAS f32x4*)(bg + 128), u1 = *(const LAS f32x4*)(bg + 132);
        float sv[2][4];
#pragma unroll
        for (int ai = 0; ai < 2; ++ai)
#pragma unroll
            for (int m = 0; m < 4; ++m) { const int rl = r0 + lrow0 + ai * 128 + m * 16; sv[ai][m] = PF[lrow0 + ai * 128 + m * 16] * (rl < cn ? 1.f : 0.f); }
        constexpr float us = MOE_FP8 ? 1.f / (FP8_SX * FP8_SW) : 1.f;
        constexpr float CG = -1.702f * 1.4426950408889634f, SA = MOE_FP8 ? FP8_SA : 1.f, KI = CG / SA;
        const f32x4 g0c = g0 * CG, g1c = g1 * CG, u0p = u0 + 1.f, u1p = u1 + 1.f;
#pragma unroll
        for (int ai = 0; ai < 2; ++ai)
#pragma unroll
            for (int m = 0; m < 4; ++m) { const int lr = lrow0 + ai * 128 + m * 16;
                const float s = sv[ai][m] * us, sc = s * CG;
                f32x4 o4[2];
#pragma unroll
                for (int n = 0; n < 2; ++n) { f32x4 t = acc[ai][0][m][n] * sc + (n ? g1c : g0c), up = acc[ai][1][m][n] * s + (n ? u1p : u0p), r;
#pragma unroll
                    for (int j = 0; j < 4; ++j) { t[j] = fmaxf(t[j], 7.f * CG); up[j] = __builtin_amdgcn_fmed3f(up[j], -6.f, 8.f);
                        r[j] = __builtin_amdgcn_rcpf(__builtin_fmaf(__builtin_amdgcn_exp2f(t[j]), KI, KI)); }
                    o4[n] = up * t * r; }
#if MOE_FP8
                unsigned w0 = 0, w1 = 0;
                w0 = __builtin_amdgcn_cvt_pk_fp8_f32(o4[0][0], o4[0][1], w0, false); w0 = __builtin_amdgcn_cvt_pk_fp8_f32(o4[0][2], o4[0][3], w0, true);
                w1 = __builtin_amdgcn_cvt_pk_fp8_f32(o4[1][0], o4[1][1], w1, false); w1 = __builtin_amdgcn_cvt_pk_fp8_f32(o4[1][2], o4[1][3], w1, true);
                v2u w; w.x = w0; w.y = w1;
                *(v2u*)(ACT + (size_t)(u.pm * 256 + lr) * DFF + col0) = w; }
#else
                v4u w; w.x = cvtpk(o4[0][0], o4[0][1]); w.y = cvtpk(o4[0][2], o4[0][3]); w.z = cvtpk(o4[1][0], o4[1][1]); w.w = cvtpk(o4[1][2], o4[1][3]);
                *(v4u*)(ACT + ((size_t)(u.pm * 256 + lr) * DFF + col0) * 2) = w; }
#endif
    }
};
struct EpiY {
    static constexpr bool PERM = true; static constexpr int ID = 8;
    unsigned char* Y; const float* bd; const float* gate; MoeTab tb; LAS unsigned char* lds;
    __device__ __forceinline__ void prefetch(const pg8::Unit& u, LAS unsigned char* lds, int wid, int lane) const {
        LAS unsigned* P = (LAS unsigned*)(lds + EPF_OFF) + wid * 64;
        const float* src;
        if (wid < 4) { const int rl = tb.tile_r0[u.pm] + wid * 64 + lane; src = gate + (size_t)u.e * ECAP + (rl < tb.cnt[u.e] ? rl : 0); }
        else src = bd + (size_t)u.e * DM + u.pn * 256 + (wid - 4) * 64 + lane;
        __builtin_amdgcn_global_load_lds((const unsigned*)src, P, 4, 0, 0);
    }
    __device__ __forceinline__ void operator()(const f32x4 (&acc)[2][2][4][2], const pg8::Unit& u, int wr, int wc, int fr, int fq) const {
        const int lrow0 = wr * 64 + fr, col0 = u.pn * 256 + wc * 32 + 8 * fq;
        const int r0 = tb.tile_r0[u.pm], cn = tb.cnt[u.e];
        const LAS float* PF = (const LAS float*)(lds + EPF_OFF);
        const LAS float* bp = PF + 256 + wc * 32 + 8 * fq;
        f32x4 bv[2][2];
#pragma unroll
        for (int bj = 0; bj < 2; ++bj) { bv[bj][0] = *(const LAS f32x4*)(bp + bj * 128); bv[bj][1] = *(const LAS f32x4*)(bp + bj * 128 + 4); }
        float gv[2][4];
#pragma unroll
        for (int ai = 0; ai < 2; ++ai)
#pragma unroll
            for (int m = 0; m < 4; ++m) { const int rl = r0 + lrow0 + ai * 128 + m * 16; gv[ai][m] = PF[lrow0 + ai * 128 + m * 16] * (rl < cn ? 1.f : 0.f); }
#pragma unroll
        for (int ai = 0; ai < 2; ++ai)
#pragma unroll
            for (int m = 0; m < 4; ++m) { const int lr = lrow0 + ai * 128 + m * 16;
                const float g = gv[ai][m];
                const size_t ro = (size_t)(u.pm * 256 + lr) * DM + col0;
#pragma unroll
                for (int bj = 0; bj < 2; ++bj) { constexpr float us = MOE_FP8 ? 1.f / (FP8_SA * FP8_SW) : 1.f;
#if Y_FP8
                    const float gs = g * FP8_SY; const f32x4 v0 = (acc[ai][bj][m][0] * us + bv[bj][0]) * gs, v1 = (acc[ai][bj][m][1] * us + bv[bj][1]) * gs;
                    v2u w; w.x = pk4_fp8(v0[0], v0[1], v0[2], v0[3]); w.y = pk4_fp8(v1[0], v1[1], v1[2], v1[3]);
                    *(v2u*)(Y + ro + bj * 128) = w; } }
#else
                    const f32x4 v0 = (acc[ai][bj][m][0] * us + bv[bj][0]) * g, v1 = (acc[ai][bj][m][1] * us + bv[bj][1]) * g;
                    v4u w; w.x = cvtpk(v0[0], v0[1]); w.y = cvtpk(v0[2], v0[3]); w.z = cvtpk(v1[0], v1[1]); w.w = cvtpk(v1[2], v1[3]);
                    *(v4u*)(Y + (ro + bj * 128) * 2) = w; } }
#endif
    }
};

template <int MI, int NI>
__device__ __forceinline__ void lds_mma(f32x16 (&acc)[MI][NI], const LAS bf16* A, int lda, const LAS bf16* B, int ldb, int K, int lane) {
    const int r = lane & 31, h = lane >> 5;
#pragma unroll 2
    for (int k0 = 0; k0 < K; k0 += 16) {
        bf16x8 a[MI], b[NI];
#pragma unroll
        for (int mi = 0; mi < MI; ++mi) a[mi] = *(const LAS bf16x8*)(A + (32 * mi + r) * lda + k0 + 8 * h);
#pragma unroll
        for (int ni = 0; ni < NI; ++ni) b[ni] = *(const LAS bf16x8*)(B + (32 * ni + r) * ldb + k0 + 8 * h);
#pragma unroll
        for (int mi = 0; mi < MI; ++mi)
#pragma unroll
            for (int ni = 0; ni < NI; ++ni) acc[mi][ni] = __builtin_amdgcn_mfma_f32_32x32x16_bf16(a[mi], b[ni], acc[mi][ni], 0, 0, 0);
    }
}
constexpr int LDP = 136;
constexpr int LDO_T = 260;

__device__ __forceinline__ float log2_gamma(float p) { return log2f(1.f - exp2f(-p)); }

__device__ __forceinline__ void p2_fixup(Frame& F) {
    bf16* Z = (bf16*)(F.ws + WS_Z);
    int lane = lane_id(); asm volatile("" : "+v"(lane));
    const int gw = F.vcu * NWAVES + F.wave, NGW = F.G * NWAVES;
    float gq[8], gk[8];
#pragma unroll
    for (int e = 0; e < 8; ++e) { const int d = (8 * lane + e) & 127; gq[e] = F.in[IN_QG][d] * 0.08838834764831845f; gk[e] = F.in[IN_KG][d]; }
    for (int m = T + gw; m < T + NMETA; m += NGW) {
        GAS v4u* p = (GAS v4u*)(Z + (size_t)m * NIN + C_DQ) + lane;
        v4u w[4];
#pragma unroll
        for (int j = 0; j < 4; ++j) w[j] = p[64 * j];
#pragma unroll
        for (int j = 0; j < 4; ++j) {
            float v[8]; v[0] = bflo(w[j].x); v[1] = bfhi(w[j].x); v[2] = bflo(w[j].y); v[3] = bfhi(w[j].y); v[4] = bflo(w[j].z); v[5] = bfhi(w[j].z); v[6] = bflo(w[j].w); v[7] = bfhi(w[j].w);
            float s = 0.f;
#pragma unroll
            for (int e = 0; e < 8; ++e) s += v[e] * v[e];
            s = red16(s);
            const float rstd = 1.f / sqrtf(s * (1.f / 128.f) + EPS);
            v4u o;
            if (j < 2) { o.x = pk2(v[0] * rstd * gq[0], v[1] * rstd * gq[1]); o.y = pk2(v[2] * rstd * gq[2], v[3] * rstd * gq[3]); o.z = pk2(v[4] * rstd * gq[4], v[5] * rstd * gq[5]); o.w = pk2(v[6] * rstd * gq[6], v[7] * rstd * gq[7]); }
            else       { o.x = pk2(v[0] * rstd * gk[0], v[1] * rstd * gk[1]); o.y = pk2(v[2] * rstd * gk[2], v[3] * rstd * gk[3]); o.z = pk2(v[4] * rstd * gk[4], v[5] * rstd * gk[5]); o.w = pk2(v[6] * rstd * gk[6], v[7] * rstd * gk[7]); }
            p[64 * j] = o;
        }
    }
}
template <int NC>
__device__ __forceinline__ void stage_transposed(LAS bf16* dst, const bf16* src, int tid) {
    const int j = tid >> 2, part = tid & 3; constexpr int PER = NC / 4;
    const bf16* s = src + (size_t)j * NIN + part * PER;
#pragma unroll
    for (int q = 0; q < PER / 8; ++q) { const v4u w = *(const GAS v4u*)(s + 8 * q); const int c0 = part * PER + 8 * q;
        dst[(c0 + 0) * LDP + j] = (bf16)(w.x & 0xffffu); dst[(c0 + 1) * LDP + j] = (bf16)(w.x >> 16);
        dst[(c0 + 2) * LDP + j] = (bf16)(w.y & 0xffffu); dst[(c0 + 3) * LDP + j] = (bf16)(w.y >> 16);
        dst[(c0 + 4) * LDP + j] = (bf16)(w.z & 0xffffu); dst[(c0 + 5) * LDP + j] = (bf16)(w.z >> 16);
        dst[(c0 + 6) * LDP + j] = (bf16)(w.w & 0xffffu); dst[(c0 + 7) * LDP + j] = (bf16)(w.w >> 16); }
}
__device__ __forceinline__ void p2_kvstates(Frame& F) {
    const bf16* Z = (const bf16*)(F.ws + WS_Z);
    bf16* KVS = (bf16*)(F.ws + WS_KVS); bf16* META = (bf16*)(F.ws + WS_META);
    LAS bf16* Vt = (LAS bf16*)F.lds;
    LAS bf16* Kt = (LAS bf16*)(F.lds + 256 * LDP * 2);
    for (int u = F.vcu; u < 16 * 32 + 4; u += F.G) {
        int tid = F.tid, wid = F.wave; asm volatile("" : "+v"(tid)); asm volatile("" : "+s"(wid));
        const int lane = tid & 63, we = wid >> 1, wd = wid & 1;
        const bool meta = u >= 512;
        const int bh = meta ? 0 : u >> 5, c = meta ? 0 : u & 31, b = bh >> 2, h = meta ? (u - 512) : (bh & 3);
        const size_t row0 = meta ? (size_t)T : (size_t)b * SEQ + 128 * c;
        const float lgf = log2_gamma(F.in[IN_DECF][h]), lgb = log2_gamma(F.in[IN_DECB][h]);
        __syncthreads();
        stage_transposed<256>(Vt, Z + row0 * NIN + C_RV + 256 * h, tid);
        const int j = tid >> 2, part = tid & 3;
        v4u kw[4];
#pragma unroll
        for (int q = 0; q < 4; ++q) kw[q] = *(const GAS v4u*)(Z + (row0 + j) * NIN + C_RK + 128 * h + 32 * part + 8 * q);
        for (int dir = 0; dir < (meta ? 1 : 2); ++dir) {
            float dec;
            if (meta) dec = (j < NMETA) ? exp2f(lgf * (float)(NMETA - 1 - j)) : 0.f;
            else dec = dir == 0 ? exp2f(lgf * (float)(127 - j)) : exp2f(lgb * (float)j);
            if (dir == 1) __syncthreads();
#pragma unroll
            for (int q = 0; q < 4; ++q) { const int d0 = 32 * part + 8 * q; const unsigned ww[4] = {kw[q].x, kw[q].y, kw[q].z, kw[q].w};
#pragma unroll
                for (int e = 0; e < 4; ++e) { Kt[(d0 + 2 * e) * LDP + j] = (bf16)f2bf(bflo(ww[e]) * dec); Kt[(d0 + 2 * e + 1) * LDP + j] = (bf16)f2bf(bfhi(ww[e]) * dec); } }
            __syncthreads();
            f32x16 acc[2][2];
#pragma unroll
            for (int a = 0; a < 2; ++a)
#pragma unroll
                for (int bb = 0; bb < 2; ++bb) acc[a][bb] = (f32x16){};
            lds_mma<2, 2>(acc, Vt + (64 * we) * LDP, LDP, Kt + (64 * wd) * LDP, LDP, 128, lane);
            bf16* dst = meta ? META + (size_t)h * 32768 : KVS + ((size_t)(bh * 2 + dir) * 32 + c) * 32768;
#pragma unroll
            for (int mi = 0; mi < 2; ++mi)
#pragma unroll
                for (int ni = 0; ni < 2; ++ni)
#pragma unroll
                    for (int r = 0; r < 16; ++r) dst[(64 * we + 32 * mi + crow(r, lane >> 5)) * 128 + 64 * wd + 32 * ni + (lane & 31)] = (bf16)f2bf(acc[mi][ni][r]);
        }
    }
    __syncthreads();
}

__device__ __forceinline__ void p3_scan(Frame& F) {
    bf16* KVS = (bf16*)(F.ws + WS_KVS); const bf16* META = (const bf16*)(F.ws + WS_META);
    int tid_ = F.tid; asm volatile("" : "+v"(tid_));
    int gt = F.vcu * 512 + tid_, NT_ = F.G * 512;
#if ATT_V2
    if ((F.G & 31) == 0) { const int sl = F.vcu & 31, q = sl & 15; if (q < 4 || q >= 12) return; gt = (((F.vcu >> 5) * 16 + (sl >> 4) * 8 + (q - 4)) * 512) + tid_; NT_ = (F.G >> 1) * 512; }
#endif
    for (int it = gt; it < 16 * 2 * 256 * 16; it += NT_) {
        const int d8 = it & 15, e = (it >> 4) & 255, dir = (it >> 12) & 1, bh = it >> 13, h = bh & 3;
        const float lg = log2_gamma(dir == 0 ? F.in[IN_DECF][h] : F.in[IN_DECB][h]);
        const float g128 = exp2f(lg * 128.f);
        GAS v4u* p = (GAS v4u*)(KVS + (size_t)(bh * 2 + dir) * 32 * 32768 + e * 128 + d8 * 8);
        float s[8];
        if (dir == 0) { const v4u a = *(const GAS v4u*)(META + (size_t)h * 32768 + e * 128 + d8 * 8);
            s[0] = bflo(a.x); s[1] = bfhi(a.x); s[2] = bflo(a.y); s[3] = bfhi(a.y); s[4] = bflo(a.z); s[5] = bfhi(a.z); s[6] = bflo(a.w); s[7] = bfhi(a.w); }
        else {
#pragma unroll
            for (int k = 0; k < 8; ++k) s[k] = 0.f; }
#pragma unroll
        for (int half = 0; half < 2; ++half) {
            v4u t[16];
#pragma unroll
            for (int i = 0; i < 16; ++i) { const int c = dir == 0 ? (half * 16 + i) : (31 - half * 16 - i); t[i] = p[(size_t)c * 4096]; }
#pragma unroll
            for (int i = 0; i < 16; ++i) { const int c = dir == 0 ? (half * 16 + i) : (31 - half * 16 - i);
                v4u o; o.x = pk2(s[0], s[1]); o.y = pk2(s[2], s[3]); o.z = pk2(s[4], s[5]); o.w = pk2(s[6], s[7]); p[(size_t)c * 4096] = o;
                s[0] = s[0] * g128 + bflo(t[i].x); s[1] = s[1] * g128 + bfhi(t[i].x); s[2] = s[2] * g128 + bflo(t[i].y); s[3] = s[3] * g128 + bfhi(t[i].y);
                s[4] = s[4] * g128 + bflo(t[i].z); s[5] = s[5] * g128 + bfhi(t[i].z); s[6] = s[6] * g128 + bflo(t[i].w); s[7] = s[7] * g128 + bfhi(t[i].w); }
        }
    }
}

namespace att {
constexpr int D = 128, NW = 8, QBLK = 32, KVBLK = 64, NT = 65;
constexpr float THR = 8.f;
constexpr int LDK = NIN, LDO = 2048;
constexpr size_t SHM_V = KVBLK * D * 2, SHM_K = KVBLK * D * 2, SHM_ATTN = 2 * SHM_V + 2 * SHM_K + NW * 64 * 4;
#define KSWZ(row, colB) ((row) * 256 + ((colB) ^ (((row) & 15) << 4)))
__device__ __forceinline__ void partialSM(f32x16& p0, f32x16& p1, float& m_reg, float& mn, float& alpha) {
    constexpr float C = 1.4426950408889634f;
    float pmax = p0[0];
#pragma unroll
    for (int r = 1; r < 16; ++r) pmax = fmaxf(pmax, p0[r]);
#pragma unroll
    for (int r = 0; r < 16; ++r) pmax = fmaxf(pmax, p1[r]);
    { auto rr = __builtin_amdgcn_permlane32_swap(__float_as_uint(pmax), __float_as_uint(pmax), false, false);
      pmax = fmaxf(__uint_as_float(rr[0]), __uint_as_float(rr[1])); }
    if (__builtin_expect(__all(pmax - m_reg <= THR), 1)) { mn = m_reg; alpha = 1.f; }
    else { mn = fmaxf(m_reg, pmax); alpha = __builtin_amdgcn_exp2f((m_reg - mn) * C); m_reg = mn; }
    const float mnC = -mn * C;
#pragma unroll
    for (int r = 0; r < 16; ++r) p0[r] = fmaf(p0[r], C, mnC);
#pragma unroll
    for (int r = 0; r < 16; ++r) p1[r] = fmaf(p1[r], C, mnC);
#pragma unroll
    for (int r = 0; r < 16; ++r) p0[r] = __builtin_amdgcn_exp2f(p0[r]);
}
__device__ __forceinline__ void finishSM(f32x16& p0, f32x16& p1, float alpha, float& l_reg, bf16x8& pa0, bf16x8& pa1, bf16x8& pa2, bf16x8& pa3) {
#pragma unroll
    for (int r = 0; r < 16; ++r) p1[r] = __builtin_amdgcn_exp2f(p1[r]);
    float ps = 0;
#pragma unroll
    for (int r = 0; r < 16; ++r) ps += p0[r];
#pragma unroll
    for (int r = 0; r < 16; ++r) ps += p1[r];
    { auto rr = __builtin_amdgcn_permlane32_swap(__float_as_uint(ps), __float_as_uint(ps), false, false);
      ps = __uint_as_float(rr[0]) + __uint_as_float(rr[1]); }
    l_reg = l_reg * alpha + ps;
#define PK4(P, BASE, OUT) do { unsigned a0 = cvtpk(P[BASE + 0], P[BASE + 1]), a1 = cvtpk(P[BASE + 2], P[BASE + 3]);   \
    unsigned b0 = cvtpk(P[BASE + 4], P[BASE + 5]), b1 = cvtpk(P[BASE + 6], P[BASE + 7]);                              \
    auto r0 = __builtin_amdgcn_permlane32_swap(a0, b0, false, false); auto r1 = __builtin_amdgcn_permlane32_swap(a1, b1, false, false); \
    v4u w = {r0[0], r1[0], r0[1], r1[1]}; OUT = *reinterpret_cast<bf16x8*>(&w); } while (0)
    PK4(p0, 0, pa0); PK4(p0, 8, pa1); PK4(p1, 0, pa2); PK4(p1, 8, pa3);
#undef PK4
}
__device__ __forceinline__ void qkt(f32x16& p0, f32x16& p1, const bf16* Ks, const bf16x8* qr, int r32, int hi, float dq, float nslope, int mode) {
    if (mode == 1) {
#pragma unroll
        for (int r = 0; r < 16; ++r) { p0[r] = r < 8 ? 0.f : -1e30f; p1[r] = -1e30f; }
    } else if (mode >= 2) {
        const float s1 = mode == 2 ? -nslope : nslope, a0 = -s1 * dq, a1 = a0 + 32.f * s1;
#pragma unroll
        for (int r = 0; r < 16; ++r) { const float c = (float)((r & 3) + 8 * (r >> 2)); p0[r] = fmaf(c, s1, a0); p1[r] = fmaf(c, s1, a1); }
    } else {
#pragma unroll
        for (int r = 0; r < 16; ++r) { const float c = (float)((r & 3) + 8 * (r >> 2)); p0[r] = nslope * fabsf(dq - c); p1[r] = nslope * fabsf(dq - 32.f - c); }
    }
#pragma unroll
    for (int d0 = 0; d0 < 8; ++d0) { const int cb = (d0 * 16 + hi * 8) * 2;
        const bf16x8 b0 = *reinterpret_cast<const bf16x8*>((const char*)Ks + KSWZ(r32, cb));
        const bf16x8 b1 = *reinterpret_cast<const bf16x8*>((const char*)Ks + KSWZ(32 + r32, cb));
        p0 = __builtin_amdgcn_mfma_f32_32x32x16_bf16(b0, qr[d0], p0, 0, 0, 0);
        p1 = __builtin_amdgcn_mfma_f32_32x32x16_bf16(b1, qr[d0], p1, 0, 0, 0); }
}
__device__ __forceinline__ int v_st(int k, int c) { const int kk = (k & ~0xC) | ((k & 4) << 1) | ((k & 8) >> 1); return ((kk >> 3) * 4 + (c >> 5)) * 512 + ((kk & 7) * 32 + (c & 31)) * 2; }
__device__ __forceinline__ int v_rd_base(int lane) { return ((lane & 3) << 3) | (((lane >> 2) & 3) << 6) | (((lane >> 4) & 1) << 5) | (((lane >> 5) & 1) << 8); }
constexpr int v_rd_off(int d0, int ks, int half) { return d0 * 512 + ks * 4096 + half * 2048; }
template <int OFF> __device__ __forceinline__ s16x4 tr_read(int vb) {
    s16x4 r; asm volatile("ds_read_b64_tr_b16 %0, %1 offset:%2" : "=&v"(r) : "v"(vb), "i"(OFF) : "memory"); return r;
}
template <int D0> __device__ __forceinline__ void pv_one(f32x16& od, int vb, bf16x8 pa0, bf16x8 pa1, bf16x8 pa2, bf16x8 pa3) {
    const s16x4 l0 = tr_read<v_rd_off(D0, 0, 0)>(vb), h0 = tr_read<v_rd_off(D0, 0, 1)>(vb), l1 = tr_read<v_rd_off(D0, 1, 0)>(vb), h1 = tr_read<v_rd_off(D0, 1, 1)>(vb);
    const s16x4 l2 = tr_read<v_rd_off(D0, 2, 0)>(vb), h2 = tr_read<v_rd_off(D0, 2, 1)>(vb), l3 = tr_read<v_rd_off(D0, 3, 0)>(vb), h3 = tr_read<v_rd_off(D0, 3, 1)>(vb);
    asm volatile("s_waitcnt lgkmcnt(0)" ::: "memory"); SBAR();
#define PK(L, H) (bf16x8){L[0], L[1], L[2], L[3], H[0], H[1], H[2], H[3]}
    od = __builtin_amdgcn_mfma_f32_32x32x16_bf16(pa0, PK(l0, h0), od, 0, 0, 0);
    od = __builtin_amdgcn_mfma_f32_32x32x16_bf16(pa1, PK(l1, h1), od, 0, 0, 0);
    od = __builtin_amdgcn_mfma_f32_32x32x16_bf16(pa2, PK(l2, h2), od, 0, 0, 0);
    od = __builtin_amdgcn_mfma_f32_32x32x16_bf16(pa3, PK(l3, h3), od, 0, 0, 0);
#undef PK
}
__device__ __forceinline__ void pv_d0(f32x16* o, int vb, bf16x8 pa0, bf16x8 pa1, bf16x8 pa2, bf16x8 pa3) {
    pv_one<0>(o[0], vb, pa0, pa1, pa2, pa3); pv_one<1>(o[1], vb, pa0, pa1, pa2, pa3); pv_one<2>(o[2], vb, pa0, pa1, pa2, pa3); pv_one<3>(o[3], vb, pa0, pa1, pa2, pa3);
}
__device__ __forceinline__ void attn_unit(const bf16* __restrict__ Zb, unsigned qoff, unsigned kreal, unsigned vreal, unsigned kmeta, unsigned vmeta,
                                          bf16* __restrict__ Ob, int q0, float nslope, int jlo, int nreal, char* lds) {
    const __amdgpu_buffer_rsrc_t rs = __builtin_amdgcn_make_buffer_rsrc((void*)Zb, 0, (int)((TM + 64) * (size_t)NIN * 2), 0x00020000);
    int tid = threadIdx.x; asm volatile("" : "+v"(tid));
    const int wid = tid >> 6, lane = tid & 63, r32 = lane & 31, hi = lane >> 5;
    bf16* V_lds = (bf16*)lds; bf16* K_lds = (bf16*)(lds + 2 * SHM_V);
    float* ws = (float*)(lds + 2 * SHM_V + 2 * SHM_K) + wid * 64; float* li_l = ws; float* al_l = ws + 32;
    float m_reg = -1e30f, l_reg = 0; f32x16 o[4] = {}; bf16x8 qr[8];
    { const unsigned qo = qoff + (unsigned)((wid * QBLK + r32) * LDK + hi * 8) * 2u;
#pragma unroll
      for (int d0 = 0; d0 < 8; ++d0) qr[d0] = __builtin_bit_cast(bf16x8, __builtin_amdgcn_raw_buffer_load_b128(rs, qo + (unsigned)(d0 * 32), 0, 0)); }
    const float qpos = (float)(q0 + wid * QBLK + r32 - 4 * hi);
    const int sr = tid >> 4, sc = (tid & 15) * 8, vst0 = v_st(sr, sc), vst1 = v_st(32 + sr, sc);
    const unsigned lvo = (unsigned)(sr * LDK + sc) * 2u;
    const int vb0 = (int)(uintptr_t)V_lds + v_rd_base(lane);
    struct { bf16x8 vs0, vs1, ks0, ks1; } sr_[1];
#define TI(p) ((p) < nreal ? jlo + (p) : 64)
#define SLOAD(i, jt) do { const unsigned ko_ = (jt) < 64 ? kreal + (unsigned)(jt) * (unsigned)(KVBLK * LDK * 2) : kmeta; const unsigned vo_ = (jt) < 64 ? vreal + (unsigned)(jt) * (unsigned)(KVBLK * LDK * 2) : vmeta; \
    sr_[i].vs0 = __builtin_bit_cast(bf16x8, __builtin_amdgcn_raw_buffer_load_b128(rs, lvo, vo_, 0)); sr_[i].vs1 = __builtin_bit_cast(bf16x8, __builtin_amdgcn_raw_buffer_load_b128(rs, lvo, vo_ + (unsigned)(32 * LDK * 2), 0)); \
    sr_[i].ks0 = __builtin_bit_cast(bf16x8, __builtin_amdgcn_raw_buffer_load_b128(rs, lvo, ko_, 0)); sr_[i].ks1 = __builtin_bit_cast(bf16x8, __builtin_amdgcn_raw_buffer_load_b128(rs, lvo, ko_ + (unsigned)(32 * LDK * 2), 0)); } while (0)
#define SWRITE(b, i) do { *(bf16x8*)((char*)V_lds + (b) * SHM_V + vst0) = sr_[i].vs0;          \
    *(bf16x8*)((char*)V_lds + (b) * SHM_V + vst1) = sr_[i].vs1; int kc = sc * 2;               \
    *(bf16x8*)((char*)K_lds + (b) * SHM_K + KSWZ(sr, kc)) = sr_[i].ks0;                       \
    *(bf16x8*)((char*)K_lds + (b) * SHM_K + KSWZ(32 + sr, kc)) = sr_[i].ks1; } while (0)
#define SWAIT() asm volatile("s_waitcnt vmcnt(0)" ::: "memory")
#define RESC(a) do { if (__any((a) < 1.f)) { if (hi == 0) al_l[r32] = (a); asm volatile("s_waitcnt lgkmcnt(0)" ::: "memory"); \
    _Pragma("unroll") for (int d = 0; d < 4; ++d) _Pragma("unroll") for (int r = 0; r < 16; ++r) o[d][r] *= al_l[crow(r, hi)]; } } while (0)
#define DQ(jt) (qpos - (float)((jt) * KVBLK))
    const int qmin = q0 + QBLK * __builtin_amdgcn_readfirstlane(wid);
#define MODE(jt) ((jt) * KVBLK + KVBLK - 1 <= qmin ? 2 : ((jt) * KVBLK >= qmin + QBLK - 1 ? 3 : 0))
    f32x16 pA0, pA1, pB0, pB1; float mnA, mnB, alA, alB; bf16x8 pa0, pa1, pa2, pa3;
    constexpr int SE = 0, SO = 0;
    const int NTu = nreal + 1;
    SLOAD(SE, jlo); asm volatile("s_waitcnt vmcnt(0)" ::: "memory"); SWRITE(0, SE); __syncthreads();
    qkt(pA0, pA1, K_lds, qr, r32, hi, DQ(jlo), nslope, MODE(jlo)); partialSM(pA0, pA1, m_reg, mnA, alA);
    SLOAD(SO, jlo + 1);
    SWAIT(); SWRITE(1, SO); __syncthreads();
    for (int p = 1; p + 1 < NTu; p += 2) {
        const int tq = TI(p + 1), tn = TI(p + 2);
        SBAR(); qkt(pB0, pB1, (bf16*)((char*)K_lds + SHM_K), qr, r32, hi, DQ(jlo + p), nslope, MODE(jlo + p));
        finishSM(pA0, pA1, alA, l_reg, pa0, pa1, pa2, pa3); SBAR();
        SLOAD(SE, tq); SBAR();
        pv_d0(o, vb0, pa0, pa1, pa2, pa3); partialSM(pB0, pB1, m_reg, mnB, alB);
        __syncthreads(); SWAIT(); SWRITE(0, SE);
        RESC(alB); __syncthreads();
        SBAR(); qkt(pA0, pA1, K_lds, qr, r32, hi, DQ(tq), nslope, p + 1 == nreal ? 1 : MODE(tq));
        finishSM(pB0, pB1, alB, l_reg, pa0, pa1, pa2, pa3); SBAR();
        SLOAD(SO, tn); SBAR();
        pv_d0(o, vb0 + (int)SHM_V, pa0, pa1, pa2, pa3); partialSM(pA0, pA1, m_reg, mnA, alA);
        __syncthreads(); SWAIT(); SWRITE(1, SO);
        RESC(alA); __syncthreads();
    }
    finishSM(pA0, pA1, alA, l_reg, pa0, pa1, pa2, pa3); SBAR();
    pv_d0(o, vb0, pa0, pa1, pa2, pa3);
    if (hi == 0) li_l[r32] = l_reg; asm volatile("s_waitcnt lgkmcnt(0)" ::: "memory");
    float rli[16];
#pragma unroll
    for (int r = 0; r < 16; ++r) rli[r] = __builtin_amdgcn_rcpf(li_l[crow(r, hi)]);
    bf16* Ow = Ob + (long)(wid * QBLK) * LDO;
#pragma unroll
    for (int r = 0; r < 16; ++r) { const int orow = crow(r, hi);
#pragma unroll
        for (int d0 = 0; d0 < 4; ++d0) Ow[(long)orow * LDO + d0 * 32 + r32] = (bf16)f2bf(o[d0][r] * rli[r]); }
    __syncthreads();
#undef TI
#undef SLOAD
#undef SWRITE
#undef SWAIT
#undef RESC
#undef DQ
#undef MODE
}
}

__device__ __forceinline__ void p3_attention(Frame& F) {
    const bf16* Z = (const bf16*)(F.ws + WS_Z); bf16* OB = (bf16*)(F.ws + WS_OBUF);
    float gmq = 0.f, gmk = 0.f;
    for (int i = lane_id(); i < 128; i += 64) { gmq = fmaxf(gmq, fabsf(F.in[IN_QG][i])); gmk = fmaxf(gmk, fabsf(F.in[IN_KG][i])); }
#pragma unroll
    for (int o = 1; o < 64; o <<= 1) { gmq = fmaxf(gmq, __shfl_xor(gmq, o)); gmk = fmaxf(gmk, __shfl_xor(gmk, o)); }
    const float thr = 32.f + 2.05f * gmq * gmk * 11.3137085f;
    for (int u = F.vcu; u < 1024; u += F.G) {
        const int rnd = u >> 8, v = u & 255, x = v >> 5, sl = v & 31, qb = sl & 15, vh = sl >> 4, b = rnd, hm = (x + 2 * rnd) & 7, h = hm >> 1, m = hm & 1;
        const float slope = exp2f(-2.f * (float)(h + 1)), nslope = -slope;
        int jlo, nreal;
        { const float dkf = fminf(thr / slope, 100000.f); const int Dk = (int)dkf, q0 = 256 * qb;
          int lo = q0 - 63 - Dk; lo = lo <= 0 ? 0 : (lo + 63) >> 6; int hi_ = (q0 + 255 + Dk) >> 6; hi_ = hi_ > 63 ? 63 : hi_;
          if (((hi_ - lo + 1) & 1) != 0) { if (lo > 0) --lo; else ++hi_; }
          jlo = __builtin_amdgcn_readfirstlane(lo); nreal = __builtin_amdgcn_readfirstlane(hi_ - lo + 1); }
        const unsigned qoff = (unsigned)(((size_t)(b * SEQ + 256 * qb) * NIN + C_DQ + (2 * h + m) * 128) * 2);
        const unsigned kreal = (unsigned)(((size_t)(b * SEQ) * NIN + C_DK + (2 * h + m) * 128) * 2), vreal = (unsigned)(((size_t)(b * SEQ) * NIN + C_DV + h * 256 + vh * 128) * 2);
        const unsigned kmeta = (unsigned)(((size_t)T * NIN + C_DK + (2 * h + m) * 128) * 2), vmeta = (unsigned)(((size_t)T * NIN + C_DV + h * 256 + vh * 128) * 2);
        bf16* Ob = OB + (size_t)(b * SEQ + 256 * qb) * 2048 + m * 1024 + h * 256 + vh * 128;
        att::attn_unit(Z, qoff, kreal, vreal, kmeta, vmeta, Ob, 256 * qb, nslope, jlo, nreal, (char*)F.lds);
    }
}


namespace att2 {
using namespace att;
constexpr int SHM_K2 = 16384, SHM_V2 = 32768;
constexpr int LDS_V = 0, LDS_K = 2 * SHM_V2, LDS_WS = LDS_K + 2 * SHM_K2;
template <int D0> __device__ __forceinline__ void pv_one2(f32x16& od, int vb, bf16x8 pa0, bf16x8 pa1, bf16x8 pa2, bf16x8 pa3) {
    constexpr int IM = (D0 >> 2) * 16384, B = D0 & 3;
    const s16x4 l0 = tr_read<IM + v_rd_off(B, 0, 0)>(vb), h0 = tr_read<IM + v_rd_off(B, 0, 1)>(vb), l1 = tr_read<IM + v_rd_off(B, 1, 0)>(vb), h1 = tr_read<IM + v_rd_off(B, 1, 1)>(vb);
    const s16x4 l2 = tr_read<IM + v_rd_off(B, 2, 0)>(vb), h2 = tr_read<IM + v_rd_off(B, 2, 1)>(vb), l3 = tr_read<IM + v_rd_off(B, 3, 0)>(vb), h3 = tr_read<IM + v_rd_off(B, 3, 1)>(vb);
    asm volatile("s_waitcnt lgkmcnt(0)" ::: "memory"); SBAR();
#define PK(L, H) (bf16x8){L[0], L[1], L[2], L[3], H[0], H[1], H[2], H[3]}
    od = __builtin_amdgcn_mfma_f32_32x32x16_bf16(pa0, PK(l0, h0), od, 0, 0, 0);
    od = __builtin_amdgcn_mfma_f32_32x32x16_bf16(pa1, PK(l1, h1), od, 0, 0, 0);
    od = __builtin_amdgcn_mfma_f32_32x32x16_bf16(pa2, PK(l2, h2), od, 0, 0, 0);
    od = __builtin_amdgcn_mfma_f32_32x32x16_bf16(pa3, PK(l3, h3), od, 0, 0, 0);
#undef PK
}
struct VFrag { s16x4 l0, h0, l1, h1, l2, h2, l3, h3; };
template <int D0> __device__ __forceinline__ void pv_load(VFrag& f, int vb) {
    constexpr int IM = (D0 >> 2) * 16384, B = D0 & 3;
    f.l0 = tr_read<IM + v_rd_off(B, 0, 0)>(vb); f.h0 = tr_read<IM + v_rd_off(B, 0, 1)>(vb); f.l1 = tr_read<IM + v_rd_off(B, 1, 0)>(vb); f.h1 = tr_read<IM + v_rd_off(B, 1, 1)>(vb);
    f.l2 = tr_read<IM + v_rd_off(B, 2, 0)>(vb); f.h2 = tr_read<IM + v_rd_off(B, 2, 1)>(vb); f.l3 = tr_read<IM + v_rd_off(B, 3, 0)>(vb); f.h3 = tr_read<IM + v_rd_off(B, 3, 1)>(vb);
}
__device__ __forceinline__ void pv_mma(f32x16& od, const VFrag& f, bf16x8 pa0, bf16x8 pa1, bf16x8 pa2, bf16x8 pa3) {
#define PK(L, H) (bf16x8){L[0], L[1], L[2], L[3], H[0], H[1], H[2], H[3]}
    od = __builtin_amdgcn_mfma_f32_32x32x16_bf16(pa0, PK(f.l0, f.h0), od, 0, 0, 0);
    od = __builtin_amdgcn_mfma_f32_32x32x16_bf16(pa1, PK(f.l1, f.h1), od, 0, 0, 0);
    od = __builtin_amdgcn_mfma_f32_32x32x16_bf16(pa2, PK(f.l2, f.h2), od, 0, 0, 0);
    od = __builtin_amdgcn_mfma_f32_32x32x16_bf16(pa3, PK(f.l3, f.h3), od, 0, 0, 0);
#undef PK
}
#define PV_WAIT8() do { asm volatile("s_waitcnt lgkmcnt(8)" ::: "memory"); SBAR(); } while (0)
#define PV_WAIT0() do { asm volatile("s_waitcnt lgkmcnt(0)" ::: "memory"); SBAR(); } while (0)
__device__ __forceinline__ void attn_unit2(const bf16* __restrict__ Zb, unsigned qoff, unsigned kreal, unsigned vreal, unsigned kmeta, unsigned vmeta,
                                           bf16* __restrict__ Ob, int q0, float nslope, int jlo, int nreal, bool with_meta, float* __restrict__ lse, char* lds) {
    const __amdgpu_buffer_rsrc_t rs = __builtin_amdgcn_make_buffer_rsrc((void*)Zb, 0, (int)((TM + 64) * (size_t)NIN * 2), 0x00020000);
    int tid = threadIdx.x; asm volatile("" : "+v"(tid));
    const int wid = tid >> 6, lane = tid & 63, r32 = lane & 31, hi = lane >> 5;
    char* V_lds = lds + LDS_V; char* K_lds = lds + LDS_K;
    float* ws = (float*)(lds + LDS_WS) + wid * 64; float* li_l = ws; float* al_l = ws + 32;
    float m_reg = -1e30f, l_reg = 0; f32x16 o[8] = {}; bf16x8 qr[8];
    { const unsigned qo = qoff + (unsigned)((wid * QBLK + r32) * LDK + hi * 8) * 2u;
#pragma unroll
      for (int d0 = 0; d0 < 8; ++d0) qr[d0] = __builtin_bit_cast(bf16x8, __builtin_amdgcn_raw_buffer_load_b128(rs, qo + (unsigned)(d0 * 32), 0, 0)); }
    const float qpos = (float)(q0 + wid * QBLK + r32 - 4 * hi);
    const int vb0 = (int)(uintptr_t)V_lds + v_rd_base(lane);
    const int wu = __builtin_amdgcn_readfirstlane(wid);
    const unsigned kl0 = (unsigned)((lane >> 4) * LDK) * 2u, kc0 = (unsigned)((lane & 15) ^ (lane >> 4));
    const unsigned vl0 = (unsigned)((8 * ((lane >> 4) & 1) + ((lane >> 2) & 3)) * LDK + 32 * (lane >> 5) + 8 * (lane & 3)) * 2u;
    const char* Zc = (const char*)Zb;
#define TI(p) ((p) < nreal ? jlo + (p) : 64)
#define DMA_TILE(jt, b) do { const unsigned ko_ = (jt) < 64 ? kreal + (unsigned)(jt) * (unsigned)(KVBLK * LDK * 2) : kmeta; const unsigned vo_ = (jt) < 64 ? vreal + (unsigned)(jt) * (unsigned)(KVBLK * LDK * 2) : vmeta; \
    _Pragma("unroll") for (int q_ = 0; q_ < 2; ++q_) { const int i_ = 2 * wu + q_; \
        __builtin_amdgcn_global_load_lds((const unsigned*)(Zc + ko_ + (unsigned)(4 * i_ * LDK * 2) + kl0 + ((kc0 ^ (unsigned)((4 * i_) & 15)) << 4)), (LAS unsigned*)(lds + LDS_K + (b) * SHM_K2 + i_ * 1024), 16, 0, 0); \
        const unsigned vu_ = (unsigned)((16 * (i_ >> 2) + 4 * ((i_ >> 1) & 1)) * LDK + 64 * (i_ & 1)) * 2u; \
        __builtin_amdgcn_global_load_lds((const unsigned*)(Zc + vo_ + vu_ + vl0), (LAS unsigned*)(lds + LDS_V + (b) * SHM_V2 + i_ * 1024), 16, 0, 0); \
        __builtin_amdgcn_global_load_lds((const unsigned*)(Zc + vo_ + vu_ + vl0 + 256u), (LAS unsigned*)(lds + LDS_V + (b) * SHM_V2 + 16384 + i_ * 1024), 16, 0, 0); } } while (0)
#define RESC(a) do { if (__any((a) < 1.f)) { if (hi == 0) al_l[r32] = (a); asm volatile("s_waitcnt lgkmcnt(0)" ::: "memory"); \
    _Pragma("unroll") for (int d = 0; d < 8; ++d) _Pragma("unroll") for (int r = 0; r < 16; ++r) o[d][r] *= al_l[crow(r, hi)]; } } while (0)
#define DQ(jt) (qpos - (float)((jt) * KVBLK))
    const int qmin = q0 + QBLK * __builtin_amdgcn_readfirstlane(wid);
#define MODE(jt) ((jt) * KVBLK + KVBLK - 1 <= qmin ? 2 : ((jt) * KVBLK >= qmin + QBLK - 1 ? 3 : 0))
    f32x16 p0, p1; float mn, al; bf16x8 pa0, pa1, pa2, pa3;
    const int NTu = nreal + (with_meta ? 1 : 0);
    DMA_TILE(jlo, 0); asm volatile("s_waitcnt vmcnt(0)" ::: "memory"); __syncthreads();
    for (int p = 0; p < NTu; ++p) {
        const int cur = p & 1, jt = TI(p), jn = TI(p + 1);
        DMA_TILE(jn, cur ^ 1);
        SBAR(); qkt(p0, p1, (const bf16*)(K_lds + cur * SHM_K2), qr, r32, hi, DQ(jt), nslope, p == nreal ? 1 : MODE(jt)); SBAR();
        partialSM(p0, p1, m_reg, mn, al);
        RESC(al);
        finishSM(p0, p1, al, l_reg, pa0, pa1, pa2, pa3); SBAR();
        { const int vb = vb0 + cur * SHM_V2; VFrag fa, fb;
          asm volatile("s_waitcnt lgkmcnt(0)" ::: "memory");
          pv_load<0>(fa, vb);
          pv_load<1>(fb, vb); PV_WAIT8(); pv_mma(o[0], fa, pa0, pa1, pa2, pa3);
          pv_load<2>(fa, vb); PV_WAIT8(); pv_mma(o[1], fb, pa0, pa1, pa2, pa3);
          pv_load<3>(fb, vb); PV_WAIT8(); pv_mma(o[2], fa, pa0, pa1, pa2, pa3);
          pv_load<4>(fa, vb); PV_WAIT8(); pv_mma(o[3], fb, pa0, pa1, pa2, pa3);
          pv_load<5>(fb, vb); PV_WAIT8(); pv_mma(o[4], fa, pa0, pa1, pa2, pa3);
          pv_load<6>(fa, vb); PV_WAIT8(); pv_mma(o[5], fb, pa0, pa1, pa2, pa3);
          pv_load<7>(fb, vb); PV_WAIT8(); pv_mma(o[6], fa, pa0, pa1, pa2, pa3);
          PV_WAIT0(); pv_mma(o[7], fb, pa0, pa1, pa2, pa3); }
        asm volatile("s_waitcnt vmcnt(0)" ::: "memory");
        __syncthreads();
    }
    if (hi == 0) li_l[r32] = l_reg; asm volatile("s_waitcnt lgkmcnt(0)" ::: "memory");
    if (lse != nullptr && hi == 0) lse[(long)(wid * QBLK + r32) * 8] = m_reg * 1.4426950408889634f + __builtin_amdgcn_logf(l_reg);
    float rli[16];
#pragma unroll
    for (int r = 0; r < 16; ++r) rli[r] = __builtin_amdgcn_rcpf(li_l[crow(r, hi)]);
    bf16* Ow = Ob + (long)(wid * QBLK) * LDO;
#pragma unroll
    for (int r = 0; r < 16; ++r) { const int orow = crow(r, hi);
#pragma unroll
        for (int d0 = 0; d0 < 8; ++d0) Ow[(long)orow * LDO + d0 * 32 + r32] = (bf16)f2bf(o[d0][r] * rli[r]); }
    __syncthreads();
#undef TI
#undef DMA_TILE
#undef RESC
#undef DQ
#undef MODE
}
}

__device__ __forceinline__ void p3_attention2(Frame& F) {
    const bf16* Z = (const bf16*)(F.ws + WS_Z); bf16* OB = (bf16*)(F.ws + WS_OBUF);
    float gmq = 0.f, gmk = 0.f;
    for (int i = lane_id(); i < 128; i += 64) { gmq = fmaxf(gmq, fabsf(F.in[IN_QG][i])); gmk = fmaxf(gmk, fabsf(F.in[IN_KG][i])); }
#pragma unroll
    for (int o = 1; o < 64; o <<= 1) { gmq = fmaxf(gmq, __shfl_xor(gmq, o)); gmk = fmaxf(gmk, __shfl_xor(gmk, o)); }
    const float thr = __builtin_bit_cast(float, __builtin_amdgcn_readfirstlane(__builtin_bit_cast(int, 32.f + 2.05f * gmq * gmk * 11.3137085f)));
    float* LSE = (float*)(F.ws + WS_LSE); bf16* OB2 = (bf16*)(F.ws + WS_OBUF2);
    if (!(F.vcu & 1)) p0_experts_q(F, CW_CONV + 192, CONV_SPLIT2, CONV_SPLIT3);
    for (int u = F.vcu;; ) {
        int b, h, m, qb, part = -1;
        if (u < 256) { const int x = u >> 5, sl = u & 31, g = 2 * x + (sl >> 4); b = g >> 2; h = 2 + ((g >> 1) & 1); m = g & 1; qb = sl & 15; }
        else {
            __syncthreads();
            if (F.tid == 0) F.MISC[20] = __hip_atomic_fetch_add(F.ctl + CW_ATT, 1u, __ATOMIC_RELAXED, __HIP_MEMORY_SCOPE_AGENT);
            __syncthreads();
            const int t = __builtin_amdgcn_readfirstlane((int)F.MISC[20]);
            if (t >= 384) break;
            if (t < 256) { const int qi = t >> 4, j = t & 15; qb = (qi & 1) ? 8 + (qi >> 1) : 7 - (qi >> 1); b = j >> 2; m = (j >> 1) & 1; part = j & 1; h = 1; }
            else { const int t2 = t - 256, qi = t2 >> 3, j = t2 & 7; qb = (qi & 1) ? 8 + (qi >> 1) : 7 - (qi >> 1); b = j >> 1; m = j & 1; h = 0; }
        }
        const float slope = exp2f(-2.f * (float)(h + 1)), nslope = -slope;
        int jlo, nreal; bool with_meta = true;
        { const float dkf = fminf(thr / slope, 100000.f); const int Dk = (int)dkf, q0 = 256 * qb;
          int lo = q0 - 63 - Dk; lo = lo <= 0 ? 0 : (lo + 63) >> 6; int hi_ = (q0 + 255 + Dk) >> 6; hi_ = hi_ > 63 ? 63 : hi_;
          if (part >= 0) { const int n = hi_ - lo + 1, na = (n + 1) >> 1; if (part == 0) hi_ = lo + na - 1; else { lo = lo + na; with_meta = false; } }
          jlo = __builtin_amdgcn_readfirstlane(lo); nreal = __builtin_amdgcn_readfirstlane(hi_ - lo + 1); }
        const unsigned qoff = (unsigned)(((size_t)(b * SEQ + 256 * qb) * NIN + C_DQ + (2 * h + m) * 128) * 2);
        const unsigned kreal = (unsigned)(((size_t)(b * SEQ) * NIN + C_DK + (2 * h + m) * 128) * 2), vreal = (unsigned)(((size_t)(b * SEQ) * NIN + C_DV + h * 256) * 2);
        const unsigned kmeta = (unsigned)(((size_t)T * NIN + C_DK + (2 * h + m) * 128) * 2), vmeta = (unsigned)(((size_t)T * NIN + C_DV + h * 256) * 2);
        bf16* Ob = (part == 1 ? OB2 : OB) + (size_t)(b * SEQ + 256 * qb) * 2048 + m * 1024 + h * 256;
        float* lsep = part >= 0 ? LSE + ((size_t)part * T + (size_t)(b * SEQ + 256 * qb)) * 8 + m * 4 + h : nullptr;
        att2::attn_unit2(Z, qoff, kreal, vreal, kmeta, vmeta, Ob, 256 * qb, nslope, jlo, nreal, with_meta, lsep, (char*)F.lds);
        if (u < 256 && !(u + F.G < 256) && (F.vcu & 1)) p0_experts_q(F, CW_CONV + 256, CONV_SPLIT3, CONV_SPLIT4);
        u = (u < 256 && u + F.G < 256) ? u + F.G : 256;
    }
}

__device__ __forceinline__ void p4_retention(Frame& F) {
    const bf16* Z = (const bf16*)(F.ws + WS_Z); const bf16* KVS = (const bf16*)(F.ws + WS_KVS); bf16* MIX = (bf16*)(F.ws + WS_MIX);
    LAS bf16* R0 = (LAS bf16*)F.lds;
    LAS bf16* R1 = (LAS bf16*)(F.lds + 128 * LDP * 2);
    LAS bf16* R2 = (LAS bf16*)(F.lds + (128 + 256) * LDP * 2);
    LAS float* SS = (LAS float*)(F.lds + (128 + 256 + 128) * LDP * 2);
    for (int u = F.vcu; u < 512; u += F.G) {
        int tid = F.tid, wid = F.wave; asm volatile("" : "+v"(tid)); asm volatile("" : "+s"(wid));
        const int lane = tid & 63, r32 = lane & 31, hi = lane >> 5, wi = wid >> 2, w4 = wid & 3;
        const int bh = u >> 5, c = u & 31, b = bh >> 2, h = bh & 3;
        const size_t row0 = (size_t)b * SEQ + 128 * c;
        const float lgf = log2_gamma(F.in[IN_DECF][h]), lgb = log2_gamma(F.in[IN_DECB][h]);
        const int i_t = tid >> 2, part = tid & 3;
        __syncthreads();
        v4u qw[4];
#pragma unroll
        for (int q = 0; q < 4; ++q) { qw[q] = *(const GAS v4u*)(Z + (row0 + i_t) * NIN + C_RQ + 128 * h + 32 * part + 8 * q);
            const v4u kk = *(const GAS v4u*)(Z + (row0 + i_t) * NIN + C_RK + 128 * h + 32 * part + 8 * q);
            *(LAS v4u*)(R0 + i_t * LDP + 32 * part + 8 * q) = qw[q]; *(LAS v4u*)(R1 + i_t * LDP + 32 * part + 8 * q) = kk; }
        v4u vreg[8], sfr[8], sbr[8];
        { const bf16* vsrc = Z + (row0 + i_t) * NIN + C_RV + 256 * h + part * 64;
          const bf16* Sf = KVS + ((size_t)(bh * 2 + 0) * 32 + c) * 32768; const bf16* Sb = KVS + ((size_t)(bh * 2 + 1) * 32 + c) * 32768;
#pragma unroll
          for (int q = 0; q < 8; ++q) { vreg[q] = *(const GAS v4u*)(vsrc + 8 * q); sfr[q] = *(const GAS v4u*)(Sf + (q * 512 + tid) * 8); sbr[q] = *(const GAS v4u*)(Sb + (q * 512 + tid) * 8); } }
        __syncthreads();
        {
            f32x16 s[2][1]; s[0][0] = (f32x16){}; s[1][0] = (f32x16){};
            lds_mma<2, 1>(s, R0 + (64 * wi) * LDP, LDP, R1 + (32 * w4) * LDP, LDP, 128, lane);
            const int jj = 32 * w4 + r32;
#pragma unroll
            for (int mi = 0; mi < 2; ++mi)
#pragma unroll
                for (int r = 0; r < 16; ++r) { const int ii = 64 * wi + 32 * mi + crow(r, hi);
                    const float dec = jj <= ii ? exp2f(lgf * (float)(ii - jj)) : exp2f(lgb * (float)(jj - ii));
                    R2[ii * LDP + jj] = (bf16)f2bf(s[mi][0][r] * dec); }
        }
        __syncthreads();
#pragma unroll
        for (int q = 0; q < 8; ++q) { const v4u w = vreg[q]; const int c0 = part * 64 + 8 * q;
            R1[(c0 + 0) * LDP + i_t] = (bf16)(w.x & 0xffffu); R1[(c0 + 1) * LDP + i_t] = (bf16)(w.x >> 16);
            R1[(c0 + 2) * LDP + i_t] = (bf16)(w.y & 0xffffu); R1[(c0 + 3) * LDP + i_t] = (bf16)(w.y >> 16);
            R1[(c0 + 4) * LDP + i_t] = (bf16)(w.z & 0xffffu); R1[(c0 + 5) * LDP + i_t] = (bf16)(w.z >> 16);
            R1[(c0 + 6) * LDP + i_t] = (bf16)(w.w & 0xffffu); R1[(c0 + 7) * LDP + i_t] = (bf16)(w.w >> 16); }
        __syncthreads();
        f32x16 acc[2][2];
#pragma unroll
        for (int a = 0; a < 2; ++a)
#pragma unroll
            for (int bb = 0; bb < 2; ++bb) acc[a][bb] = (f32x16){};
        lds_mma<2, 2>(acc, R2 + (64 * wi) * LDP, LDP, R1 + (64 * w4) * LDP, LDP, 128, lane);
        for (int dir = 0; dir < 2; ++dir) {
            __syncthreads();
            const float qd = dir == 0 ? exp2f(lgf * (float)(i_t + 1)) : exp2f(lgb * (float)(128 - i_t));
#pragma unroll
            for (int q = 0; q < 4; ++q) { v4u w; w.x = pk2(bflo(qw[q].x) * qd, bfhi(qw[q].x) * qd); w.y = pk2(bflo(qw[q].y) * qd, bfhi(qw[q].y) * qd);
                w.z = pk2(bflo(qw[q].z) * qd, bfhi(qw[q].z) * qd); w.w = pk2(bflo(qw[q].w) * qd, bfhi(qw[q].w) * qd);
                *(LAS v4u*)(R0 + i_t * LDP + 32 * part + 8 * q) = w; }
#pragma unroll
            for (int q = 0; q < 8; ++q) { const int idx = (q * 512 + tid) * 8; const int e = idx >> 7, d = idx & 127;
                *(LAS v4u*)(R1 + e * LDP + d) = dir == 0 ? sfr[q] : sbr[q]; }
            __syncthreads();
            lds_mma<2, 2>(acc, R0 + (64 * wi) * LDP, LDP, R1 + (64 * w4) * LDP, LDP, 128, lane);
        }
        const f32x4 g0 = *(const GAS f32x4*)(F.in[IN_RETG] + 256 * h + (tid & 31) * 8), g1 = *(const GAS f32x4*)(F.in[IN_RETG] + 256 * h + (tid & 31) * 8 + 4);
        v4u rgw[8];
#pragma unroll
        for (int q = 0; q < 8; ++q) { const int id = q * 512 + tid; rgw[q] = *(const GAS v4u*)(Z + (row0 + (id >> 5)) * NIN + C_RG + 256 * h + (id & 31) * 8); }
#pragma unroll
        for (int mi = 0; mi < 2; ++mi)
#pragma unroll
            for (int r = 0; r < 16; ++r) { float s = acc[mi][0][r] * acc[mi][0][r] + acc[mi][1][r] * acc[mi][1][r];
                s = red_x16(red16(s));
                if (r32 == 0) SS[(64 * wi + 32 * mi + crow(r, hi)) * 4 + w4] = s; }
        __syncthreads();
        if (tid < 128) { const float s = SS[tid * 4] + SS[tid * 4 + 1] + SS[tid * 4 + 2] + SS[tid * 4 + 3]; SS[512 + tid] = 1.f / sqrtf(s * (1.f / 256.f) + EPS); }
        __syncthreads();
        LAS float* OT = (LAS float*)F.lds;
#pragma unroll
        for (int mi = 0; mi < 2; ++mi)
#pragma unroll
            for (int r = 0; r < 16; ++r) { const int ii = 64 * wi + 32 * mi + crow(r, hi); const float rstd = SS[512 + ii];
                OT[ii * LDO_T + 64 * w4 + r32] = acc[mi][0][r] * rstd; OT[ii * LDO_T + 64 * w4 + 32 + r32] = acc[mi][1][r] * rstd; }
        __syncthreads();
#pragma unroll
        for (int q = 0; q < 8; ++q) { const int id = q * 512 + tid, ii = id >> 5, e0 = (id & 31) * 8;
            const f32x4 v0 = *(const LAS f32x4*)(OT + ii * LDO_T + e0), v1 = *(const LAS f32x4*)(OT + ii * LDO_T + e0 + 4);
            const v4u gw = rgw[q];
            const float x[8] = {bflo(gw.x), bfhi(gw.x), bflo(gw.y), bfhi(gw.y), bflo(gw.z), bfhi(gw.z), bflo(gw.w), bfhi(gw.w)};
            const float vv[8] = {v0.x * g0.x, v0.y * g0.y, v0.z * g0.z, v0.w * g0.w, v1.x * g1.x, v1.y * g1.y, v1.z * g1.z, v1.w * g1.w};
            float o[8];
#pragma unroll
            for (int e = 0; e < 8; ++e) o[e] = vv[e] * x[e] * __builtin_amdgcn_rcpf(1.f + __builtin_amdgcn_exp2f(-1.4426950408889634f * x[e]));
            v4u w; w.x = pk2(o[0], o[1]); w.y = pk2(o[2], o[3]); w.z = pk2(o[4], o[5]); w.w = pk2(o[6], o[7]);
            *(GAS v4u*)(MIX + (row0 + ii) * DM + 256 * h + e0) = w; }
    }
    __syncthreads();
}
__device__ __forceinline__ void p4_attn_post(Frame& F) {
    const bf16* OB = (const bf16*)(F.ws + WS_OBUF); bf16* MIX = (bf16*)(F.ws + WS_MIX);
    int lane = lane_id(); asm volatile("" : "+v"(lane));
    const int gw = F.vcu * NWAVES + F.wave, NGW = F.G * NWAVES;
    float a = 0.f, bsum = 0.f;
    for (int i = lane; i < 128; i += 64) { a += F.in[IN_LQ1][i] * F.in[IN_LK1][i]; bsum += F.in[IN_LQ2][i] * F.in[IN_LK2][i]; }
    const float lam = expf(wave_sum(a)) - expf(wave_sum(bsum)) + LAM_INIT;
    for (int m = gw; m < T; m += NGW) {
        const GAS v2u* o1 = (const GAS v2u*)(OB + (size_t)m * 2048) + lane;
        const GAS v2u* o2 = (const GAS v2u*)(OB + (size_t)m * 2048 + 1024) + lane;
        const GAS f32x4* gp = (const GAS f32x4*)F.in[IN_DOG] + lane;
        GAS v2u* op = (GAS v2u*)(MIX + (size_t)m * DM + 1024) + lane;
#pragma unroll
        for (int h = 0; h < 4; ++h) { const v2u w1 = o1[64 * h], w2 = o2[64 * h]; const f32x4 g = gp[64 * h];
            f32x4 x1 = (f32x4){bflo(w1.x), bfhi(w1.x), bflo(w1.y), bfhi(w1.y)}, x2 = (f32x4){bflo(w2.x), bfhi(w2.x), bflo(w2.y), bfhi(w2.y)};
#if ATT_V2
            if (h == 1) {
                const bf16* OB2 = (const bf16*)(F.ws + WS_OBUF2); const float* LSE = (const float*)(F.ws + WS_LSE);
                const v2u u1 = *((const GAS v2u*)(OB2 + (size_t)m * 2048) + lane + 64 * h), u2 = *((const GAS v2u*)(OB2 + (size_t)m * 2048 + 1024) + lane + 64 * h);
                const f32x4 y1 = (f32x4){bflo(u1.x), bfhi(u1.x), bflo(u1.y), bfhi(u1.y)}, y2 = (f32x4){bflo(u2.x), bfhi(u2.x), bflo(u2.y), bfhi(u2.y)};
                const float la1 = LSE[(size_t)m * 8 + 0 * 4 + 1], lb1 = LSE[((size_t)T + m) * 8 + 0 * 4 + 1], la2 = LSE[(size_t)m * 8 + 1 * 4 + 1], lb2 = LSE[((size_t)T + m) * 8 + 1 * 4 + 1];
                const float wa1 = __builtin_amdgcn_rcpf(1.f + __builtin_amdgcn_exp2f(lb1 - la1)), wa2 = __builtin_amdgcn_rcpf(1.f + __builtin_amdgcn_exp2f(lb2 - la2));
                x1 = x1 * wa1 + y1 * (1.f - wa1); x2 = x2 * wa2 + y2 * (1.f - wa2);
            }
#endif
            const f32x4 v = x1 - x2 * lam; const float s = wave_sum((v.x * v.x + v.y * v.y) + (v.z * v.z + v.w * v.w));
            const float rstd = (1.f - LAM_INIT) / sqrtf(s * (1.f / 256.f) + EPS);
            v2u w; w.x = pk2(v.x * rstd * g.x, v.y * rstd * g.y); w.y = pk2(v.z * rstd * g.z, v.w * rstd * g.w); op[64 * h] = w; }
    }
}

__device__ __forceinline__ void p6_route(Frame& F) {
    const bf16* H1 = (const bf16*)(F.ws + WS_U); unsigned char* XT = F.ws + WS_XT;
    int* TOK = (int*)(F.ws + WS_TOK); float* GATE = (float*)(F.ws + WS_GATE); float* RS = (float*)(F.ws + WS_RS); int* SLOT = (int*)(F.ws + WS_SLOT);
    LAS float* part = (LAS float*)F.lds;
    LAS float* ssqp = (LAS float*)(F.lds + 2 * 4 * 32 * 33 * 4);
    const float* wr_ = F.in[IN_WR]; const float* gain = F.in[IN_FNG];
    for (int u = F.vcu; u < T / 64; u += F.G) {
        int tid = F.tid, wid = F.wave; asm volatile("" : "+v"(tid)); asm volatile("" : "+s"(wid));
        const int lane = tid & 63, bl = wid >> 2, kq = wid & 3, i = lane & 31, kk = lane >> 5;
        const int row = u * 64 + bl * 32 + i;
        const bf16* hrow = H1 + (size_t)row * DM;
        f32x16 acc = (f32x16){}; float ssq = 0.f;
#pragma unroll 4
        for (int it = 0; it < 32; ++it) {
            const int k = 512 * kq + 16 * it + 8 * kk;
            const v4u hw = *(const GAS v4u*)(hrow + k);
            const f32x4 h0 = (f32x4){bflo(hw.x), bfhi(hw.x), bflo(hw.y), bfhi(hw.y)}, h1 = (f32x4){bflo(hw.z), bfhi(hw.z), bflo(hw.w), bfhi(hw.w)};
            const f32x4 g0 = *(const GAS f32x4*)(gain + k), g1 = *(const GAS f32x4*)(gain + k + 4);
            const f32x4 a0 = h0 * g0, a1 = h1 * g1;
            ssq += (h0.x * h0.x + h0.y * h0.y) + (h0.z * h0.z + h0.w * h0.w) + (h1.x * h1.x + h1.y * h1.y) + (h1.z * h1.z + h1.w * h1.w);
#if MOE_FP8
            { v2u w; w.x = pk4_fp8(a0.x * FP8_SX, a0.y * FP8_SX, a0.z * FP8_SX, a0.w * FP8_SX); w.y = pk4_fp8(a1.x * FP8_SX, a1.y * FP8_SX, a1.z * FP8_SX, a1.w * FP8_SX);
              *(GAS v2u*)(XT + (size_t)row * DM + k) = w; }
#else
            { v4u w; w.x = pk2(a0.x, a0.y); w.y = pk2(a0.z, a0.w); w.z = pk2(a1.x, a1.y); w.w = pk2(a1.z, a1.w);
              *(GAS v4u*)(XT + ((size_t)row * DM + k) * 2) = w; }
#endif
            const float av[8] = {a0.x, a0.y, a0.z, a0.w, a1.x, a1.y, a1.z, a1.w};
#pragma unroll
            for (int e = 0; e < 8; ++e) { const float bw = wr_[(size_t)(k + e) * NE + i]; acc = __builtin_amdgcn_mfma_f32_32x32x2f32(av[e], bw, acc, 0, 0, 0); }
        }
        ssq = red_x32(ssq);
        __syncthreads();
#pragma unroll
        for (int r = 0; r < 16; ++r) part[((bl * 4 + kq) * 32 + crow(r, kk)) * 33 + i] = acc[r];
        if (kk == 0) ssqp[(bl * 4 + kq) * 32 + i] = ssq;
        __syncthreads();
        if (tid < 64) {
            const int b2 = tid >> 5, ii = tid & 31, tokn = u * 64 + tid;
            const float sq = ssqp[(b2 * 4 + 0) * 32 + ii] + ssqp[(b2 * 4 + 1) * 32 + ii] + ssqp[(b2 * 4 + 2) * 32 + ii] + ssqp[(b2 * 4 + 3) * 32 + ii];
            const float rstd = 1.f / sqrtf(sq * (1.f / DM) + EPS);
            float lg[NE];
#pragma unroll
            for (int e = 0; e < NE; ++e) { const float s = part[((b2 * 4 + 0) * 32 + ii) * 33 + e] + part[((b2 * 4 + 1) * 32 + ii) * 33 + e] + part[((b2 * 4 + 2) * 32 + ii) * 33 + e] + part[((b2 * 4 + 3) * 32 + ii) * 33 + e];
                lg[e] = s * rstd + F.in[IN_BR][e]; }
            int sel[TOPK]; float val[TOPK]; unsigned used = 0u;
#pragma unroll
            for (int k = 0; k < TOPK; ++k) { float best = -3.0e38f; int bi = 0;
#pragma unroll
                for (int e = 0; e < NE; ++e) { const bool ok = !((used >> e) & 1u) && lg[e] > best; best = ok ? lg[e] : best; bi = ok ? e : bi; }
                sel[k] = bi; val[k] = best; used |= 1u << bi; }
            float ex[TOPK], den = 0.f;
#pragma unroll
            for (int k = 0; k < TOPK; ++k) { ex[k] = expf(val[k] - val[0]); den += ex[k]; }
#pragma unroll
            for (int k = 0; k < TOPK; ++k) { const int e = sel[k];
                const unsigned pos = __hip_atomic_fetch_add(F.ctl + CW_CNT + 64 * e, 1u, __ATOMIC_RELAXED, __HIP_MEMORY_SCOPE_AGENT);
                const size_t s = (size_t)e * ECAP + pos;
                TOK[s] = tokn; GATE[s] = ex[k] / den; RS[s] = rstd; SLOT[tokn * 4 + k] = (int)s; }
        }
    }
    __syncthreads();
}
__device__ __forceinline__ void p9_combine(Frame& F) {
    MoeTab tb = moe_tab(F);
    const int* SLOT = (const int*)(F.ws + WS_SLOT);
    int lane = lane_id(); asm volatile("" : "+v"(lane));
    const int gw = F.vcu * NWAVES + F.wave, NGW = F.G * NWAVES;
#if Y_FP8
    const unsigned char* Y = F.ws + WS_Y;
    for (int m = gw; m < T; m += NGW) {
        size_t yr[4];
#pragma unroll
        for (int k = 0; k < 4; ++k) { const int s = SLOT[m * 4 + k]; const int e = s / ECAP, pos = s % ECAP; yr[k] = (size_t)(tb.rbase[e] + pos) * DM; }
        float* op = F.out + (size_t)m * DM; const bf16* hp = (const bf16*)(F.ws + WS_U) + (size_t)m * DM;
#pragma unroll
        for (int j = 0; j < 2; ++j) { const int col = 1024 * j + 16 * lane;
            v4u w[4];
#pragma unroll
            for (int k = 0; k < 4; ++k) w[k] = *(const GAS v4u*)(Y + yr[k] + col);
            f32x4 a[4];
            { const v4u h0 = *(const GAS v4u*)(hp + col), h1 = *(const GAS v4u*)(hp + col + 8);
              a[0] = (f32x4){bflo(h0.x), bfhi(h0.x), bflo(h0.y), bfhi(h0.y)}; a[1] = (f32x4){bflo(h0.z), bfhi(h0.z), bflo(h0.w), bfhi(h0.w)};
              a[2] = (f32x4){bflo(h1.x), bfhi(h1.x), bflo(h1.y), bfhi(h1.y)}; a[3] = (f32x4){bflo(h1.z), bfhi(h1.z), bflo(h1.w), bfhi(h1.w)}; }
            float acc[16];
#pragma unroll
            for (int i = 0; i < 16; ++i) acc[i] = 0.f;
#pragma unroll
            for (int k = 0; k < 4; ++k) { const unsigned ww[4] = {w[k].x, w[k].y, w[k].z, w[k].w};
#pragma unroll
                for (int q = 0; q < 4; ++q) { const f32x2 lo = __builtin_amdgcn_cvt_pk_f32_fp8(ww[q], false), hi = __builtin_amdgcn_cvt_pk_f32_fp8(ww[q], true);
                    acc[4 * q] += lo.x; acc[4 * q + 1] += lo.y; acc[4 * q + 2] += hi.x; acc[4 * q + 3] += hi.y; } }
#pragma unroll
            for (int q = 0; q < 4; ++q) { f32x4 o = a[q]; o.x += acc[4 * q] * (1.f / FP8_SY); o.y += acc[4 * q + 1] * (1.f / FP8_SY); o.z += acc[4 * q + 2] * (1.f / FP8_SY); o.w += acc[4 * q + 3] * (1.f / FP8_SY);
                *(GAS f32x4*)(op + col + 4 * q) = o; } }
    }
#else
    const bf16* Y = (const bf16*)(F.ws + WS_Y);
    for (int m = gw; m < T; m += NGW) {
        size_t yr[4];
#pragma unroll
        for (int k = 0; k < 4; ++k) { const int s = SLOT[m * 4 + k]; const int e = s / ECAP, pos = s % ECAP; yr[k] = (size_t)(tb.rbase[e] + pos) * DM; }
        float* op = F.out + (size_t)m * DM;
#pragma unroll
        for (int j = 0; j < 4; ++j) { const int col = 512 * j + 8 * lane;
            f32x4 a0 = *(const GAS f32x4*)(op + col), a1 = *(const GAS f32x4*)(op + col + 4);
#pragma unroll
            for (int k = 0; k < 4; ++k) { const v4u w = *(const GAS v4u*)(Y + yr[k] + col);
                a0.x += bflo(w.x); a0.y += bfhi(w.x); a0.z += bflo(w.y); a0.w += bfhi(w.y); a1.x += bflo(w.z); a1.y += bfhi(w.z); a1.z += bflo(w.w); a1.w += bfhi(w.w); }
            *(GAS f32x4*)(op + col) = a0; *(GAS f32x4*)(op + col + 4) = a1; }
    }
#endif
}

struct Args { const float* in[22]; float* out; unsigned char* ws; int ph_lo, ph_hi; };
__global__ void __launch_bounds__(NWAVES * 64, 2) fwd(Args args) {
    extern __shared__ __attribute__((aligned(16))) unsigned char lds[];
    Frame F;
    F.lds = (LAS unsigned char*)lds;
    F.MISC = (volatile LAS unsigned*)(F.lds + MISC_OFF);
    F.tid = threadIdx.x; F.wave = __builtin_amdgcn_readfirstlane(F.tid >> 6);
    F.G = gridDim.x; { const int bx = blockIdx.x; F.vcu = (F.G % 8 == 0) ? (bx % 8) * (F.G / 8) + bx / 8 : bx; }
    F.ws = args.ws; F.ctl = (gu32*)(args.ws + WS_CTL); F.out = args.out;
#pragma unroll
    for (int i = 0; i < 22; ++i) F.in[i] = args.in[i];
    for (int u = F.tid; u < (LDS_BYTES - MISC_OFF) / 4; u += NWAVES * 64) ((LAS unsigned*)(F.lds + MISC_OFF))[u] = 0u;
    __syncthreads();
    const int lo = args.ph_lo, hi = args.ph_hi;
    XcdBarrier bar; bar.bar = (unsigned*)(F.ctl + CW_BAR); bar.x = 0; bar.st = nullptr;
    if (hi - lo > 1) bar = xcd_barrier_post((unsigned*)(F.ctl + CW_BAR), F.MISC + 8);
#ifndef PHASE_MASK
#define PHASE_MASK 0x3ff
#endif
#define IN(k) (((PHASE_MASK >> (k)) & 1) && lo <= (k) && (k) < hi)
#define BOTH(k) (IN(k) && IN((k) + 1))
#define GRID_BAR() xcd_barrier(bar)
#ifndef PROBE_DUP
#define PROBE_DUP 0
#endif
#define DUP(k) ((PROBE_DUP >> (k)) & 1)

    if (IN(0)) { p0_prologue(F); if (BOTH(0)) GRID_BAR(); }
    if (IN(1)) {
        p1_meta_rows(F);
        if ((F.vcu & 31) < NCONV) p0_experts_q(F, CW_CONV, 0, CONV_SPLIT);
        QueueSched S{(const bf16*)(F.ws + WS_U), (const bf16*)(F.ws + WS_WIN), T / 2048, NIN / 256, DM * 2, (int)(blockIdx.x & 7), F.ctl + CW_Q1, (volatile LAS int*)(F.MISC + 16)};
        EpiZ E{(bf16*)(F.ws + WS_Z), F.in[IN_QG], F.in[IN_KG], (LAS float*)(F.lds + 131072)};
        pg8::gemm_phase<EpiZ, QueueSched, false, false>(F.lds, DM * 2, S, E);
        p0_experts_q(F, CW_CONV + 64, CONV_SPLIT, CONV_SPLIT2);
        if (BOTH(1)) GRID_BAR();
    }
    if (IN(2)) { p2_fixup(F); p2_kvstates(F); if (DUP(2)) p2_kvstates(F); if (BOTH(2)) GRID_BAR(); }
    if (IN(3)) {
#ifndef NO_SCAN
        p3_scan(F);
#endif
#ifndef NO_ATT
#if ATT_V2
        p3_attention2(F); if (DUP(3)) p3_attention2(F);
        p0_experts_q(F, CW_CONV + 128, CONV_SPLIT4, CONV_TICKETS);
#else
        p3_attention(F); if (DUP(3)) p3_attention(F);
#endif
#endif
 if (BOTH(3)) GRID_BAR(); }
    if (IN(4)) {
#ifndef NO_RET
        p4_retention(F); if (DUP(4)) p4_retention(F);
#endif
#ifndef NO_POST
        p4_attn_post(F); if (DUP(10)) p4_attn_post(F);
#endif
 if (BOTH(4)) GRID_BAR(); }
    if (IN(5)) {
        DenseSched S{(const bf16*)(F.ws + WS_MIX), (const bf16*)(F.ws + WS_WOUT), T / 256, DM / 256, DM * 2, F.G, (int)blockIdx.x};
        EpiOut E{F.in[IN_X], (bf16*)(F.ws + WS_U)};
        pg8::gemm_phase<EpiOut, DenseSched, false, false>(F.lds, DM * 2, S, E); if (DUP(5)) pg8::gemm_phase<EpiOut, DenseSched, false, false>(F.lds, DM * 2, S, E);
        if (BOTH(5)) GRID_BAR();
    }
    if (IN(6)) { p6_route(F); if (BOTH(6)) GRID_BAR(); }
    if (IN(7)) {
        moe_build_tables(F);
        MoeTab tb = moe_tab(F);
        constexpr int EB = MOE_FP8 ? 1 : 2;
        MoeSched S{F.ws + WS_XT, F.ws + WS_WGU, (size_t)4096 * DM * EB, 16, DM * EB, F.G, (int)blockIdx.x, tb, (const int*)(F.ws + WS_TOK)};
        EpiAct E{F.ws + WS_ACT, F.in[IN_BGU], (const float*)(F.ws + WS_RS), tb, F.lds};
        pg8::gemm_phase<EpiAct, MoeSched, true, MOE_FP8 != 0>(F.lds, DM * EB, S, E); if (DUP(7)) pg8::gemm_phase<EpiAct, MoeSched, true, MOE_FP8 != 0>(F.lds, DM * EB, S, E);
        if (BOTH(7)) GRID_BAR();
    }
    if (IN(8)) {
        if (!IN(7)) moe_build_tables(F);
        MoeTab tb = moe_tab(F);
        constexpr int EB = MOE_FP8 ? 1 : 2;
        MoeSched S{F.ws + WS_ACT, F.ws + WS_WD, (size_t)DM * DFF * EB, 8, DFF * EB, F.G, (int)blockIdx.x, tb, nullptr};
        EpiY E{F.ws + WS_Y, F.in[IN_BD], (const float*)(F.ws + WS_GATE), tb, F.lds};
        pg8::gemm_phase<EpiY, MoeSched, false, MOE_FP8 != 0>(F.lds, DFF * EB, S, E); if (DUP(8)) pg8::gemm_phase<EpiY, MoeSched, false, MOE_FP8 != 0>(F.lds, DFF * EB, S, E);
        if (BOTH(8)) GRID_BAR();
    }
    if (IN(9)) { if (!IN(8)) moe_build_tables(F); p9_combine(F); }
#undef IN
#undef BOTH
#undef GRID_BAR
}

extern "C" void kernel_launch(void* const* d_in, const int* in_sizes, int n_in, void* d_out, int out_size, void* d_ws, size_t ws_size, hipStream_t stream) {
    static int grid = 0;
    if (grid == 0) {
        if (n_in != 22 || out_size != T * DM || ws_size < WS_END) { fprintf(stderr, "kernel_launch: unexpected shapes (n_in %d out %d ws %zu)\n", n_in, out_size, ws_size); grid = -1; return; }
        int dev = 0, cus = 0;
        if (hipGetDevice(&dev) != hipSuccess || hipDeviceGetAttribute(&cus, hipDeviceAttributeMultiprocessorCount, dev) != hipSuccess) { grid = -1; return; }
        if (hipFuncSetAttribute((const void*)fwd, hipFuncAttributeMaxDynamicSharedMemorySize, LDS_BYTES) != hipSuccess) { fprintf(stderr, "kernel_launch: hipFuncSetAttribute failed\n"); grid = -1; return; }
        int per_cu = 0;
        if (hipOccupancyMaxActiveBlocksPerMultiprocessor(&per_cu, (const void*)fwd, NWAVES * 64, LDS_BYTES) != hipSuccess || per_cu < 1) fprintf(stderr, "kernel_launch: occupancy query says %d\n", per_cu);
        (void)hipGetLastError();
        grid = cus;
    }
    if (grid < 0) return;
    (void)hipMemsetAsync((char*)d_ws + WS_CTL, 0, CTL_ZERO_BYTES, stream);
    Args a{};
    for (int i = 0; i < 22; ++i) a.in[i] = (const float*)d_in[i];
    a.out = (float*)d_out; a.ws = (unsigned char*)d_ws;
#if MK_SPLIT
    for (int p = 0; p < NPHASE; ++p) { a.ph_lo = p; a.ph_hi = p + 1; hipLaunchKernelGGL(fwd, dim3(grid), dim3(NWAVES * 64), LDS_BYTES, stream, a); }
#else
    a.ph_lo = 0; a.ph_hi = NPHASE; hipLaunchKernelGGL(fwd, dim3(grid), dim3(NWAVES * 64), LDS_BYTES, stream, a);
#endif
    const hipError_t le = hipPeekAtLastError();
    if (le != hipSuccess) fprintf(stderr, "kernel_launch: launch failed: %s\n", hipGetErrorName(le));
}
```

```cpp
#include <hip/hip_runtime.h>
#include <cstdio>
#include <cstdint>

#ifndef MK_SPLIT
#define MK_SPLIT 0
#endif

#ifndef ATT_V2
#define ATT_V2 1
#endif
#ifndef Y_FP8
#define Y_FP8 1
#endif
#ifndef MOE_FP8
#define MOE_FP8 1
#endif
#define GAS __attribute__((address_space(1)))
#define LAS __attribute__((address_space(3)))
typedef unsigned short bf16;
typedef unsigned v4u __attribute__((ext_vector_type(4)));
typedef unsigned v2u __attribute__((ext_vector_type(2)));
typedef float f32x2 __attribute__((ext_vector_type(2)));
typedef float f32x4 __attribute__((ext_vector_type(4)));
typedef float f32x8 __attribute__((ext_vector_type(8)));
typedef float f32x16 __attribute__((ext_vector_type(16)));
typedef short bf16x8 __attribute__((ext_vector_type(8)));
typedef short s16x4 __attribute__((ext_vector_type(4)));
typedef GAS unsigned gu32;

constexpr int BATCH = 4, SEQ = 4096, DM = 2048, NMETA = 16;
constexpr int T = BATCH * SEQ;
constexpr int TM = T + 256;
constexpr int NIN = 6144;
constexpr int C_RQ = 0, C_RK = 512, C_RV = 1024, C_RG = 2048, C_DQ = 3072, C_DK = 4096, C_DV = 5120;
constexpr int NE = 32, TOPK = 4, DFF = 2048;
constexpr int ECAP = T;
constexpr int MAXTILES = (T * TOPK) / 256 + NE;
constexpr float EPS = 1e-6f;
constexpr float LAM_INIT = 0.2f;
constexpr int NPHASE = 10;

constexpr size_t MiB = 1u << 20;
constexpr size_t WS_CTL = 0, CTL_ZERO_BYTES = 1 * MiB;
constexpr size_t WS_WIN = 1 * MiB;
constexpr size_t WS_WOUT = 25 * MiB;
constexpr size_t WS_WGU = 33 * MiB;
constexpr size_t WS_WD = 545 * MiB;
constexpr size_t WS_U = 801 * MiB;
constexpr size_t WS_Z = 866 * MiB;
constexpr size_t WS_KVS = 1062 * MiB;
constexpr size_t WS_META = WS_KVS + 128 * MiB;
constexpr size_t WS_OBUF = 1191 * MiB;
constexpr size_t WS_OBUF2 = WS_OBUF + 64 * MiB;
constexpr size_t WS_LSE = 1454 * MiB;
constexpr size_t WS_MIX = 1319 * MiB;
constexpr size_t WS_XT = 1383 * MiB;
constexpr size_t WS_TOK = 1447 * MiB;
constexpr size_t WS_GATE = 1449 * MiB;
constexpr size_t WS_RS = 1451 * MiB;
constexpr size_t WS_SLOT = 1453 * MiB;
constexpr size_t WS_ACT = 1455 * MiB;
constexpr size_t WS_Y = 1743 * MiB;
constexpr size_t WS_END = 2031 * MiB;
constexpr int CW_TMO = 0;
constexpr int CW_BAR = 4096;
constexpr int CW_CNT = 16384;
constexpr int CW_CONV = 28672;
constexpr int CW_ATT = 24576;
constexpr int CW_P1 = 49152;
constexpr int CW_RET = 45056;
constexpr int CW_KV = 32768, CW_SC = 36864, CW_AT = 40960;
constexpr int CW_Q1 = 20480;
#ifndef NCONV
#define CONV_BLOCK2x4 1
#define CONV_P1 0
#define CONV_P2 8
#define CONV_P3 51
#define CONV_P4 94
#define CONV_SPLIT3 ((CONV_TICKETS * CONV_P3) / 100)
#define CONV_SPLIT4 ((CONV_TICKETS * CONV_P4) / 100)
#define CONV_SPLIT ((CONV_TICKETS * CONV_P1) / 100)
#define CONV_SPLIT2 ((CONV_TICKETS * CONV_P2) / 100)
#define NCONV 16
#endif

constexpr int LDS_BYTES = 163840;
constexpr int SCR_BYTES = 155648;
constexpr int TAB_OFF = SCR_BYTES;
constexpr int MISC_OFF = SCR_BYTES + 4096;
constexpr int EPF_OFF = 139264;
constexpr int NWAVES = 8;

#define LDS_WAIT() asm volatile("s_waitcnt lgkmcnt(0)" ::: "memory")
#define VM_WAIT() asm volatile("s_waitcnt vmcnt(0)" ::: "memory")
#define SBAR() __builtin_amdgcn_sched_barrier(0)

__device__ __forceinline__ unsigned f2bf(float f) { unsigned u = __builtin_bit_cast(unsigned, f); return (u + 0x7fffu + ((u >> 16) & 1u)) >> 16; }
__device__ __forceinline__ unsigned pk2(float lo, float hi) { unsigned r; asm("v_cvt_pk_bf16_f32 %0, %1, %2" : "=v"(r) : "v"(lo), "v"(hi)); return r; }
__device__ __forceinline__ float bf2f(unsigned b) { return __builtin_bit_cast(float, b << 16); }
__device__ __forceinline__ float bflo(unsigned w) { return __builtin_bit_cast(float, w << 16); }
__device__ __forceinline__ float bfhi(unsigned w) { return __builtin_bit_cast(float, w & 0xffff0000u); }
__device__ __forceinline__ unsigned cvtpk(float lo, float hi) { unsigned r; asm volatile("v_cvt_pk_bf16_f32 %0, %1, %2" : "=v"(r) : "v"(lo), "v"(hi)); return r; }
__device__ __forceinline__ float clamp448(float x) { return fminf(fmaxf(x, -448.f), 448.f); }
__device__ __forceinline__ unsigned pk4_fp8(float a, float b, float c, float d) {
    unsigned w = 0; w = __builtin_amdgcn_cvt_pk_fp8_f32(clamp448(a), clamp448(b), w, false); w = __builtin_amdgcn_cvt_pk_fp8_f32(clamp448(c), clamp448(d), w, true); return w; }
constexpr float FP8_SW = 512.f, FP8_SX = 8.f, FP8_SA = 4.f, FP8_SY = 32.f;
__device__ __forceinline__ int lane_id() { int l = threadIdx.x & 63; asm volatile("" : "+v"(l)); return l; }
__device__ __forceinline__ int crow(int r, int hi) { return (r & 3) + 8 * (r >> 2) + 4 * hi; }
template <int CTRL> __device__ __forceinline__ float dpp_mov(float v) { return __builtin_bit_cast(float, __builtin_amdgcn_update_dpp(0, __builtin_bit_cast(int, v), CTRL, 0xf, 0xf, true)); }
__device__ __forceinline__ float red16(float v) {
    v += dpp_mov<0xB1>(v); v += dpp_mov<0x4E>(v); v += dpp_mov<0x141>(v); v += dpp_mov<0x140>(v); return v; }
__device__ __forceinline__ float red_x16(float v) {
    float a = v, b = v; asm volatile("s_nop 1\n\tv_permlane16_swap_b32 %0, %1\n\ts_nop 1" : "+v"(a), "+v"(b)); return a + b; }
__device__ __forceinline__ float red_x32(float v) {
    float a = v, b = v; asm volatile("s_nop 1\n\tv_permlane32_swap_b32 %0, %1\n\ts_nop 1" : "+v"(a), "+v"(b)); return a + b; }
__device__ __forceinline__ float wave_sum(float v) {
    return red_x32(red_x16(red16(v)));
}

#define XB_TMO      128
#define XB_XCNT(j)  (256  + 64 * (j))
#define XB_XSUB(j)  (1280 + 64 * (j))
#define XB_XGEN(j)  (2304 + 64 * (j))
#define XB_TOP      3328
#define XB_TOPGEN   3392
#define XCD_BAR_WORDS 3456
#define XB_SPIN_CAP (1u << 18)
__device__ __forceinline__ unsigned xb_ld(unsigned* p)              { return __hip_atomic_load(p, __ATOMIC_RELAXED, __HIP_MEMORY_SCOPE_AGENT); }
__device__ __forceinline__ unsigned xb_add(unsigned* p, unsigned v) { return __hip_atomic_fetch_add(p, v, __ATOMIC_RELAXED, __HIP_MEMORY_SCOPE_AGENT); }
__device__ __forceinline__ unsigned xb_xcc_id() { return (unsigned)__builtin_amdgcn_s_getreg((3 << 11) | 20) & 0xFu; }
#define XB_SPIN(cond, bar) do { unsigned _sp = 0; while (cond) { __builtin_amdgcn_s_sleep(1); \
    if ((++_sp & 255u) == 0u) { if (xb_ld(&(bar)[XB_TMO])) break; if (_sp > XB_SPIN_CAP) { atomicAdd(&(bar)[XB_TMO], 1u); break; } } } } while (0)
struct XcdBarrier { unsigned* bar; unsigned x; volatile LAS unsigned* st; };
__device__ __forceinline__ XcdBarrier xcd_barrier_post(unsigned* bar, volatile LAS unsigned* st) {
    XcdBarrier b; b.bar = bar; b.x = xb_xcc_id(); b.st = st;
    if (threadIdx.x == 0) (void)xb_add(&bar[XB_XCNT(b.x)], 1u);
    return b;
}
__device__ __forceinline__ void xcd_barrier_complete(unsigned* bar, unsigned x, unsigned& nloc, unsigned& nx) {
    const unsigned G = gridDim.x * gridDim.y * gridDim.z;
    unsigned sum, cnt, mine, sp = 0u;
    for (;;) {
        sum = 0u; cnt = 0u; mine = 0u;
#pragma unroll
        for (unsigned j = 0; j < 16; ++j) { const unsigned c = xb_ld(&bar[XB_XCNT(j)]); sum += c; cnt += (c > 0u) ? 1u : 0u; mine = (j == x) ? c : mine; }
        if (sum == G) break;
        __builtin_amdgcn_s_sleep(1);
        if ((++sp & 255u) == 0u) { if (xb_ld(&bar[XB_TMO])) break; if (sp > XB_SPIN_CAP) { atomicAdd(&bar[XB_TMO], 1u); break; } }
    }
    nloc = mine > 0u ? mine : 1u; nx = cnt > 0u ? cnt : 1u;
}
__device__ __forceinline__ void xcd_barrier(const XcdBarrier& b) {
    asm volatile("s_waitcnt vmcnt(0)" ::: "memory");
    __syncthreads();
    if (threadIdx.x == 0) {
        unsigned* bar = b.bar;
        __builtin_amdgcn_s_waitcnt(0);
        unsigned nloc = b.st[0], nx = b.st[1];
        if (nloc == 0u) { xcd_barrier_complete(bar, b.x, nloc, nx); b.st[0] = nloc; b.st[1] = nx; }
        const unsigned old = xb_add(&bar[XB_XSUB(b.x)], 1u);
        const unsigned gen = old / nloc, want = (gen + 1u) * nx;
        unsigned og = 0u;
        if (old + 1u == (gen + 1u) * nloc) {
            __builtin_amdgcn_fence(__ATOMIC_RELEASE, "agent");
            asm volatile("s_waitcnt vmcnt(0)" ::: "memory");
            og = xb_add(&bar[XB_TOP], 1u) + 1u;
        }
        if (og != want) XB_SPIN(xb_ld(&bar[XB_TOP]) < want, bar);
        __builtin_amdgcn_fence(__ATOMIC_ACQUIRE, "agent");
        asm volatile("s_waitcnt vmcnt(0)" ::: "memory");
    }
    __syncthreads();
}

__device__ __forceinline__ void split_arrive(const XcdBarrier& b, unsigned* ctr) {
    asm volatile("s_waitcnt vmcnt(0)" ::: "memory");
    __syncthreads();
    if (threadIdx.x == 0) {
        const unsigned nloc = b.st[0];
        const unsigned old = xb_add(&ctr[64 * b.x], 1u);
        if (old + 1u == nloc) { __builtin_amdgcn_fence(__ATOMIC_RELEASE, "agent"); asm volatile("s_waitcnt vmcnt(0)" ::: "memory"); xb_add(&ctr[1024], 1u); }
    }
}
__device__ __forceinline__ void split_wait(const XcdBarrier& b, unsigned* ctr) {
    if (threadIdx.x == 0) { const unsigned nx = b.st[1];
        XB_SPIN(xb_ld(&ctr[1024]) < nx, b.bar); __builtin_amdgcn_fence(__ATOMIC_ACQUIRE, "agent"); asm volatile("s_waitcnt vmcnt(0)" ::: "memory"); }
    __syncthreads();
}

#ifndef PG8_SP2
#define PG8_SP2 true
#endif
#ifndef PG8_ALIGN
#define PG8_ALIGN true
#endif
namespace pg8 {
constexpr int BM = 256, BK = 64, HALF = 128, HTB = HALF * BK * 2, STAGE_BYTES = 8 * HTB, NXCD = 8, WGM = 8;
__host__ __device__ __forceinline__ int lds_byte(int r, int c) { return r * 128 + ((((c >> 3)) ^ ((r >> 1) & 7)) << 4) + (c & 7) * 2; }
__host__ __device__ __forceinline__ void stage_rc(int b, int& R, int& C) { R = b >> 7; C = ((((b >> 4) & 7) ^ ((R >> 1) & 7)) << 3) + ((b & 15) >> 1); }
__host__ __device__ __forceinline__ int perm32(int rho) { const int n = rho >> 4, i = rho & 15; return 8 * (i >> 2) + 4 * n + (i & 3); }
struct Unit { int pm, pn, e; };
__device__ __forceinline__ bool order_next(int i, int G, int c, int nM, int nN, int& pm, int& pn) {
    const int nwg = nM * nN; const long L = (long)i * G + c; if (L >= nwg) return false;
    int wgid = (int)L; { const int q = nwg / NXCD, r = nwg % NXCD, xcd = wgid % NXCD, off = wgid / NXCD; wgid = (xcd < r ? xcd * (q + 1) : r * (q + 1) + (xcd - r) * q) + off; }
    const int nig = WGM * nN, gid = wgid / nig, fm = gid * WGM, gsz = (nM - fm) < WGM ? (nM - fm) : WGM;
    pm = fm + ((wgid % nig) % gsz); pn = (wgid % nig) / gsz; return true;
}

typedef int i32x8 __attribute__((ext_vector_type(8)));
__device__ __forceinline__ i32x8 cat16(bf16x8 lo, bf16x8 hi) { const v4u a = __builtin_bit_cast(v4u, lo), b = __builtin_bit_cast(v4u, hi); return (i32x8){(int)a.x, (int)a.y, (int)a.z, (int)a.w, (int)b.x, (int)b.y, (int)b.z, (int)b.w}; }
template <class Epi, class Sched, bool GATHER, bool FP8, bool SP2 = PG8_SP2, bool ALIGN_EPI = PG8_ALIGN>
__device__ __forceinline__ void gemm_phase(LAS unsigned char* lds, const int pitchB, const Sched& S, const Epi& E) {
    const int tid = threadIdx.x, wid = __builtin_amdgcn_readfirstlane(tid >> 6), lane = tid & 63, wr = wid >> 2, wc = wid & 3, fr = lane & 15, fq = lane >> 4;
    const int nt = pitchB / 128;
    const size_t kstep = (size_t)128;
    const size_t hstep = (size_t)HALF * pitchB;
    unsigned voffB[2], voA[4];
#pragma unroll
    for (int i = 0; i < 2; ++i) { int R, C; stage_rc(tid * 16 + i * 8192, R, C); const int Rb = Epi::PERM ? ((R & ~31) + perm32(R & 31)) : R;
        voA[i] = (unsigned)(R * pitchB + C * 2); voA[2 + i] = voA[i] + (unsigned)hstep; voffB[i] = (unsigned)(Rb * pitchB + C * 2); }
    const unsigned ldsw = (unsigned)wid * 1024u;
    const int aoffk[2] = {lds_byte(wr * 64 + fr, fq * 8), lds_byte(wr * 64 + fr, 32 + fq * 8)}, boffk[2] = {lds_byte(wc * 32 + fr, fq * 8), lds_byte(wc * 32 + fr, 32 + fq * 8)};
#define PG8_SA(b, h) (((b) * 2 + (h)) * HTB)
#define PG8_SB(b, h) ((4 + (b) * 2 + (h)) * HTB)
#define PG8_STAGE2(bufoff, gbase, o0, o1) do { \
        __builtin_amdgcn_global_load_lds((const unsigned*)((const char*)(gbase) + (o0)), (LAS unsigned*)(lds + (bufoff) + ldsw), 16, 0, 0); \
        __builtin_amdgcn_global_load_lds((const unsigned*)((const char*)(gbase) + (o1)), (LAS unsigned*)(lds + (bufoff) + ldsw + 8192), 16, 0, 0); } while (0)
#define PG8_STAGEB(bufoff, gbase) PG8_STAGE2(bufoff, gbase, voffB[0], voffB[1])
#ifndef PROBE_LDS2
#define PROBE_LDS2 0
#endif
#ifndef PROBE_EPI
#define PROBE_EPI 0
#endif
#define PG8_LDA1(dst, b, h) do { _Pragma("unroll") for (int m = 0; m < 4; ++m) _Pragma("unroll") for (int k = 0; k < 2; ++k) dst[m][k] = *(const LAS bf16x8*)(lds + PG8_SA(b, h) + aoffk[k] + m * 2048); } while (0)
#define PG8_LDA(dst, b, h) do { if (PROBE_LDS2) { _Pragma("unroll") for (int m = 0; m < 4; ++m) _Pragma("unroll") for (int k = 0; k < 2; ++k) { bf16x8 t_ = *(const LAS bf16x8*)(lds + PG8_SA(b, h) + aoffk[k] + m * 2048); asm volatile("" :: "v"(t_)); } asm volatile("" ::: "memory"); } PG8_LDA1(dst, b, h); } while (0)
#define PG8_LDB1(dst, b, h) do { _Pragma("unroll") for (int n = 0; n < 2; ++n) _Pragma("unroll") for (int k = 0; k < 2; ++k) dst[n][k] = *(const LAS bf16x8*)(lds + PG8_SB(b, h) + boffk[k] + n * 2048); } while (0)
#define PG8_LDB(dst, b, h) do { if (PROBE_LDS2) { _Pragma("unroll") for (int n = 0; n < 2; ++n) _Pragma("unroll") for (int k = 0; k < 2; ++k) { bf16x8 t_ = *(const LAS bf16x8*)(lds + PG8_SB(b, h) + boffk[k] + n * 2048); asm volatile("" :: "v"(t_)); } asm volatile("" ::: "memory"); } PG8_LDB1(dst, b, h); } while (0)
#define PG8_MMA(ai, bj, At, Bt) do { __builtin_amdgcn_s_setprio(1); _Pragma("unroll") for (int m = 0; m < 4; ++m) _Pragma("unroll") for (int n = 0; n < 2; ++n) { \
        if constexpr (FP8) { const i32x8 b8_ = cat16(Bt[n][0], Bt[n][1]), a8_ = cat16(At[m][0], At[m][1]); \
            asm volatile("v_mfma_scale_f32_16x16x128_f8f6f4 %0, %1, %2, %0, %3, %3 op_sel_hi:[0,0,0]" : "+v"(acc[ai][bj][m][n]) : "v"(b8_), "v"(a8_), "v"(one_scale)); } \
        else { _Pragma("unroll") for (int k = 0; k < 2; ++k) acc[ai][bj][m][n] = __builtin_amdgcn_mfma_f32_16x16x32_bf16(Bt[n][k], At[m][k], acc[ai][bj][m][n], 0, 0, 0); } } \
        __builtin_amdgcn_s_setprio(0); } while (0)
#define PG8_WAIT_V(n) asm volatile("s_waitcnt vmcnt(" #n ")" ::: "memory")
#define PG8_WAIT_L(n) asm volatile("s_waitcnt lgkmcnt(" #n ")" ::: "memory")
#define PG8_BAR __builtin_amdgcn_s_barrier()
#define PG8_SCHED __builtin_amdgcn_sched_barrier(0)
    Unit cur, nxt; int ui = 0;
    if (!S.next(0, cur)) return;
    const unsigned one_scale = 0x7F7F7F7Fu;
    f32x4 acc[2][2][4][2];
#pragma unroll
    for (int a = 0; a < 2; ++a)
#pragma unroll
        for (int b = 0; b < 2; ++b)
#pragma unroll
            for (int m = 0; m < 4; ++m)
#pragma unroll
                for (int n = 0; n < 2; ++n) acc[a][b][m][n] = (f32x4){0.f, 0.f, 0.f, 0.f};
    bf16x8 At[4][2], B0[2][2], B1[2][2];
    const char* cA = S.a_base(cur); const char* cB = S.b_base(cur);
    unsigned voN[4];
    if constexpr (GATHER) { S.a_off(cur, tid, voA); }
#pragma unroll
    for (int i = 0; i < 4; ++i) voN[i] = voA[i];
    if constexpr (SP2) {
        PG8_STAGEB(PG8_SB(0, 0), cB); PG8_STAGEB(PG8_SB(0, 1), cB + hstep); PG8_STAGE2(PG8_SA(0, 0), cA, voA[0], voA[1]); PG8_STAGE2(PG8_SA(0, 1), cA, voA[2], voA[3]);
        if (wr == 1) PG8_BAR;
        PG8_WAIT_V(2); PG8_BAR;
        PG8_STAGEB(PG8_SB(1, 0), cB + kstep); PG8_STAGE2(PG8_SA(1, 0), cA + kstep, voA[0], voA[1]); PG8_STAGEB(PG8_SB(1, 1), cB + hstep + kstep);
        PG8_WAIT_V(6); PG8_BAR;
    } else {
        PG8_STAGEB(PG8_SB(0, 0), cB); PG8_STAGE2(PG8_SA(0, 0), cA, voA[0], voA[1]); PG8_STAGEB(PG8_SB(0, 1), cB + hstep); PG8_STAGE2(PG8_SA(0, 1), cA, voA[2], voA[3]);
        if (wr == 1) PG8_BAR;
        PG8_WAIT_V(4); PG8_BAR;
        PG8_STAGEB(PG8_SB(1, 0), cB + kstep); PG8_STAGE2(PG8_SA(1, 0), cA + kstep, voA[0], voA[1]); PG8_STAGEB(PG8_SB(1, 1), cB + hstep + kstep);
        PG8_WAIT_V(6); PG8_BAR;
    }
    for (;;) {
        const bool has_next = S.next(ui + 1, nxt);
        const bool skip1 = S.skip_hi(cur);
        const char* nA = has_next ? S.a_base(nxt) : cA; const char* nB = has_next ? S.b_base(nxt) : cB;
        for (int t = 0; t < nt; t += 2) {
            const bool last = (t == nt - 2);
            const char* a1 = cA + (size_t)(t + 1) * kstep;
            const char* a2 = last ? nA : cA + (size_t)(t + 2) * kstep; const char* b2 = last ? nB : cB + (size_t)(t + 2) * kstep;
            const char* a3 = a2 + kstep; const char* b3 = b2 + kstep;
            unsigned v2[4];
            if constexpr (GATHER) {
                if (t == nt - 4 && has_next) S.a_tok_dma(nxt, lds, wid, lane);
                if (last && has_next) S.a_off_lds(lds, tid, voN);
#pragma unroll
                for (int i = 0; i < 4; ++i) v2[i] = last ? voN[i] : voA[i];
            } else {
#pragma unroll
                for (int i = 0; i < 4; ++i) v2[i] = voA[i];
            }
            if (last) E.prefetch(cur, lds, wid, lane);
            if constexpr (SP2) {
            PG8_LDB(B0, 0, 0); PG8_LDB(B1, 0, 1); PG8_SCHED; PG8_LDA(At, 0, 0); PG8_STAGE2(PG8_SA(1, 1), a1, voA[2], voA[3]);
            PG8_WAIT_V(8); PG8_WAIT_L(0); PG8_BAR; PG8_MMA(0, 0, At, B0); PG8_MMA(0, 1, At, B1); PG8_BAR; PG8_SCHED;
            PG8_LDA(At, 0, 1); PG8_STAGEB(PG8_SB(0, 0), b2); PG8_STAGEB(PG8_SB(0, 1), b2 + hstep); PG8_STAGE2(PG8_SA(0, 0), a2, v2[0], v2[1]);
            PG8_WAIT_V(8); PG8_WAIT_L(0); PG8_BAR; if (!skip1) { PG8_MMA(1, 0, At, B0); PG8_MMA(1, 1, At, B1); } PG8_BAR; PG8_SCHED;
            PG8_LDB(B0, 1, 0); PG8_LDB(B1, 1, 1); PG8_SCHED; PG8_LDA(At, 1, 0); PG8_STAGE2(PG8_SA(0, 1), a2, v2[2], v2[3]);
            PG8_WAIT_V(8); PG8_WAIT_L(0); PG8_BAR; PG8_MMA(0, 0, At, B0); PG8_MMA(0, 1, At, B1); PG8_BAR; PG8_SCHED;
            PG8_LDA(At, 1, 1); PG8_STAGEB(PG8_SB(1, 0), b3); PG8_STAGEB(PG8_SB(1, 1), b3 + hstep); PG8_STAGE2(PG8_SA(1, 0), a3, v2[0], v2[1]);
            PG8_WAIT_V(8); PG8_WAIT_L(0); PG8_BAR; if (!skip1) { PG8_MMA(1, 0, At, B0); PG8_MMA(1, 1, At, B1); } PG8_BAR; PG8_SCHED;
            } else {
            PG8_LDB(B0, 0, 0); PG8_SCHED; PG8_LDA(At, 0, 0); PG8_STAGE2(PG8_SA(1, 1), a1, voA[2], voA[3]);
            PG8_WAIT_L(8); PG8_BAR; PG8_WAIT_L(0); PG8_MMA(0, 0, At, B0); PG8_BAR; PG8_SCHED;
            PG8_LDB(B1, 0, 1); PG8_STAGEB(PG8_SB(0, 0), b2);
            PG8_BAR; PG8_WAIT_L(0); PG8_MMA(0, 1, At, B1); PG8_BAR;
            PG8_LDA(At, 0, 1); PG8_STAGE2(PG8_SA(0, 0), a2, v2[0], v2[1]);
            PG8_BAR; PG8_WAIT_L(0); PG8_MMA(1, 0, At, B0); PG8_BAR; PG8_SCHED;
            PG8_STAGEB(PG8_SB(0, 1), b2 + hstep);
            PG8_WAIT_V(6); PG8_BAR; PG8_MMA(1, 1, At, B1); PG8_BAR;
            PG8_LDB(B0, 1, 0); PG8_SCHED; PG8_LDA(At, 1, 0); PG8_STAGE2(PG8_SA(0, 1), a2, v2[2], v2[3]);
            PG8_WAIT_L(8); PG8_BAR; PG8_WAIT_L(0); PG8_MMA(0, 0, At, B0); PG8_BAR; PG8_SCHED;
            PG8_LDB(B1, 1, 1); PG8_STAGEB(PG8_SB(1, 0), b3);
            PG8_BAR; PG8_WAIT_L(0); PG8_MMA(0, 1, At, B1); PG8_BAR;
            PG8_LDA(At, 1, 1); PG8_STAGE2(PG8_SA(1, 0), a3, v2[0], v2[1]);
            PG8_BAR; PG8_WAIT_L(0); PG8_MMA(1, 0, At, B0); PG8_BAR; PG8_SCHED;
            PG8_STAGEB(PG8_SB(1, 1), b3 + hstep);
            PG8_WAIT_V(6); PG8_BAR; PG8_MMA(1, 1, At, B1); PG8_BAR;
            }
        }
        if constexpr (ALIGN_EPI) { if (wr == 0) PG8_BAR; }
        if constexpr (FP8) asm volatile("s_nop 15\n\ts_nop 15" ::: "memory");
        E(acc, cur, wr, wc, fr, fq);
        if (PROBE_EPI & Epi::ID) { asm volatile("" ::: "memory"); E(acc, cur, wr, wc, fr, fq); }
        if (!has_next) break;
#pragma unroll
        for (int a = 0; a < 2; ++a)
#pragma unroll
            for (int b = 0; b < 2; ++b)
#pragma unroll
                for (int m = 0; m < 4; ++m)
#pragma unroll
                    for (int n = 0; n < 2; ++n) acc[a][b][m][n] = (f32x4){0.f, 0.f, 0.f, 0.f};
        if constexpr (FP8) asm volatile("s_nop 4" ::: "memory");
        cur = nxt; cA = nA; cB = nB; ++ui;
        if constexpr (ALIGN_EPI) { if (wr == 1) PG8_BAR; }
        if constexpr (GATHER) {
#pragma unroll
            for (int i = 0; i < 4; ++i) voA[i] = voN[i];
        }
    }
    PG8_WAIT_V(0);
    if constexpr (!ALIGN_EPI) { if (wr == 0) PG8_BAR; }
    PG8_BAR;
#undef PG8_SA
#undef PG8_SB
#undef PG8_STAGE2
#undef PG8_STAGEB
#undef PG8_LDA
#undef PG8_LDB
#undef PG8_LDA1
#undef PG8_LDB1
#undef PG8_MMA
#undef PG8_WAIT_V
#undef PG8_WAIT_L
#undef PG8_BAR
#undef PG8_SCHED
}
}

struct Frame {
    LAS unsigned char* lds;
    volatile LAS unsigned* MISC;
    gu32* ctl;
    int tid, wave, vcu, G;
    const float* in[22];
    float* out;
    unsigned char* ws;
};
#define IN_X 0
#define IN_META 1
#define IN_ANG 2
#define IN_WIN 3
#define IN_DECF 4
#define IN_DECB 5
#define IN_RETG 6
#define IN_QG 7
#define IN_KG 8
#define IN_LQ1 9
#define IN_LK1 10
#define IN_LQ2 11
#define IN_LK2 12
#define IN_DOG 13
#define IN_WOUT 14
#define IN_FNG 15
#define IN_WR 16
#define IN_BR 17
#define IN_WGU 18
#define IN_BGU 19
#define IN_WD 20
#define IN_BD 21

__device__ __forceinline__ void p0_transpose_item(const float* W, int K, int N, bf16* WT, int row_off, LAS float* scr, int kb, int nb, int lane) {
    const int k0 = 64 * kb, n0 = 32 * nb;
#pragma unroll 8
    for (int i = 0; i < 32; ++i) { const int kk = 2 * i + (lane >> 5); scr[kk * 33 + (lane & 31)] = __builtin_nontemporal_load((const GAS float*)(W + (size_t)(k0 + kk) * N + n0 + (lane & 31))); }
    LDS_WAIT(); asm volatile("" ::: "memory");
    const int c = lane & 7;
#pragma unroll
    for (int j = 0; j < 4; ++j) { const int n = (lane >> 3) + 8 * j; const LAS float* s = scr + (8 * c) * 33 + n;
        v4u o; o.x = pk2(s[0 * 33], s[1 * 33]); o.y = pk2(s[2 * 33], s[3 * 33]); o.z = pk2(s[4 * 33], s[5 * 33]); o.w = pk2(s[6 * 33], s[7 * 33]);
        *(GAS v4u*)(WT + (size_t)(row_off + n0 + n) * K + k0 + 8 * c) = o; }
    LDS_WAIT(); asm volatile("" ::: "memory");
}
__device__ __forceinline__ void p0_transpose_item_fp8(const float* W, int K, int N, unsigned char* WT, int row_off, LAS unsigned* tl, int kb, int nb, int lane, float sc) {
    const int k0 = 128 * kb, n0 = 64 * nb, n4 = lane & 15, kq = lane >> 4;
    const float* src = W + (size_t)(k0 + 4 * kq) * N + n0 + 4 * n4;
#pragma unroll
    for (int half = 0; half < 2; ++half) {
        f32x4 v[4][4];
#pragma unroll
        for (int g = 0; g < 4; ++g)
#pragma unroll
            for (int e = 0; e < 4; ++e) v[g][e] = __builtin_nontemporal_load((const GAS f32x4*)(src + (size_t)(16 * (4 * half + g) + e) * N));
#pragma unroll
        for (int g = 0; g < 4; ++g)
#pragma unroll
            for (int c = 0; c < 4; ++c) tl[(4 * n4 + c) * 33 + 4 * (4 * half + g) + kq] = pk4_fp8(v[g][0][c] * sc, v[g][1][c] * sc, v[g][2][c] * sc, v[g][3][c] * sc);
    }
    LDS_WAIT(); asm volatile("" ::: "memory");
    const int ch = lane & 7;
#pragma unroll
    for (int j = 0; j < 8; ++j) { const int n = (lane >> 3) + 8 * j; const LAS unsigned* t = tl + n * 33 + 4 * ch;
        v4u o; o.x = t[0]; o.y = t[1]; o.z = t[2]; o.w = t[3];
        __builtin_nontemporal_store(o, (GAS v4u*)(WT + (size_t)(row_off + n0 + n) * K + k0 + 16 * ch)); }
    LDS_WAIT(); asm volatile("" ::: "memory");
}
__device__ __forceinline__ void rms_row_to_bf16(int lane, const float* xrow, const float* gain, bf16* orow) {
    const GAS f32x4* xr = (const GAS f32x4*)xrow + lane;
    const GAS f32x4* gr = (const GAS f32x4*)gain + lane;
    f32x4 v[8]; float s = 0.f;
#pragma unroll
    for (int j = 0; j < 8; ++j) { v[j] = __builtin_nontemporal_load(xr + 64 * j); s += (v[j].x * v[j].x + v[j].y * v[j].y) + (v[j].z * v[j].z + v[j].w * v[j].w); }
    const float rstd = 1.f / sqrtf(wave_sum(s) * (1.f / DM) + EPS);
    GAS v2u* o8 = (GAS v2u*)orow + lane;
#pragma unroll
    for (int j = 0; j < 8; ++j) { const f32x4 g = gr[64 * j]; v2u w; w.x = pk2(v[j].x * rstd * g.x, v[j].y * rstd * g.y); w.y = pk2(v[j].z * rstd * g.z, v[j].w * rstd * g.w); o8[64 * j] = w; }
}
__device__ __forceinline__ void p0_prologue(Frame& F) {
    LAS float* scr = (LAS float*)(F.lds + F.wave * 19456);
    const int gw = F.vcu * NWAVES + F.wave, NGW = F.G * NWAVES;
    bf16* WIN_T = (bf16*)(F.ws + WS_WIN); bf16* WOUT_T = (bf16*)(F.ws + WS_WOUT);
    constexpr int I_IN = 32 * (NIN / 32), I_OUT = 32 * (DM / 32);
    for (int it = gw; it < I_IN + I_OUT; it += NGW) {
        int r = it;
        if (r < I_IN) { const int nbk = NIN / 32; p0_transpose_item(F.in[IN_WIN], DM, NIN, WIN_T, 0, scr, r / nbk, r % nbk, lane_id()); continue; } r -= I_IN;
        { const int nbk = DM / 32; p0_transpose_item(F.in[IN_WOUT], DM, DM, WOUT_T, 0, scr, r / nbk, r % nbk, lane_id()); }
    }
    bf16* U = (bf16*)(F.ws + WS_U);
    for (int m = gw; m < T + NMETA; m += NGW) {
        if (m < T) rms_row_to_bf16(lane_id(), F.in[IN_X] + (size_t)m * DM, F.in[IN_ANG], U + (size_t)m * DM);
        else rms_row_to_bf16(lane_id(), F.in[IN_META] + (size_t)(m - T) * DM, F.in[IN_ANG], U + (size_t)m * DM);
    }
    { bf16* Z = (bf16*)(F.ws + WS_Z);
      for (int m = T + NMETA + gw; m < T + 128; m += NGW) { GAS v4u* o = (GAS v4u*)(Z + (size_t)m * NIN) + lane_id();
#pragma unroll
          for (int j = 0; j < 12; ++j) o[64 * j] = (v4u){0u, 0u, 0u, 0u}; } }
}
__device__ __forceinline__ void p0_expert_item(Frame& F, int it) {
    LAS float* scr = (LAS float*)(F.lds + F.wave * 19456);
#if MOE_FP8
    constexpr int KB_E = 16;
    unsigned char* WGU_T = F.ws + WS_WGU; unsigned char* WD_T = F.ws + WS_WD;
#else
    constexpr int KB_E = 32;
    bf16* WGU_T = (bf16*)(F.ws + WS_WGU); bf16* WD_T = (bf16*)(F.ws + WS_WD);
#endif
    constexpr int NBW = MOE_FP8 ? 64 : 32;
    constexpr int I_GU = KB_E * (4096 / NBW), I_D = KB_E * (DM / NBW);
    constexpr int NITEMS = NE * I_GU + NE * I_D;
        int r = it;
        if (r < NE * I_GU) { const int e = r / I_GU, q = r % I_GU, nbk = 4096 / NBW, kb = q / nbk, nb = q % nbk, n0 = NBW * nb;
            const int j = n0 & 2047, isup = n0 >> 11, dest = (j >> 7) * 256 + isup * 128 + (j & 127);
#if MOE_FP8
            p0_transpose_item_fp8(F.in[IN_WGU] + (size_t)e * DM * 4096, DM, 4096, WGU_T + (size_t)e * 4096 * DM, dest - n0, (LAS unsigned*)scr, kb, nb, lane_id(), FP8_SW); return; } r -= NE * I_GU;
#else
            p0_transpose_item(F.in[IN_WGU] + (size_t)e * DM * 4096, DM, 4096, WGU_T + (size_t)e * 4096 * DM, dest - n0, scr, kb, nb, lane_id()); return; } r -= NE * I_GU;
#endif
        { const int e = r / I_D, q = r % I_D, nbk = DM / NBW;
#if MOE_FP8
            p0_transpose_item_fp8(F.in[IN_WD] + (size_t)e * DFF * DM, DFF, DM, WD_T + (size_t)e * DM * DFF, 0, (LAS unsigned*)scr, q / nbk, q % nbk, lane_id(), FP8_SW); }
#else
            p0_transpose_item(F.in[IN_WD] + (size_t)e * DFF * DM, DFF, DM, WD_T + (size_t)e * DM * DFF, 0, scr, q / nbk, q % nbk, lane_id()); }
#endif

}
constexpr int CONV_ITEMS = NE * ((MOE_FP8 ? 16 : 32) * (4096 / (MOE_FP8 ? 64 : 32))) + NE * ((MOE_FP8 ? 16 : 32) * (DM / (MOE_FP8 ? 64 : 32))), CONV_TICKETS = CONV_ITEMS / NWAVES;
__device__ __forceinline__ void p0_experts_q(Frame& F, int cw, int first, int last) {
    for (;;) {
        __syncthreads();
        if (F.tid == 0) F.MISC[22] = __hip_atomic_fetch_add(F.ctl + cw, 1u, __ATOMIC_RELAXED, __HIP_MEMORY_SCOPE_AGENT);
        __syncthreads();
        const int t = first + __builtin_amdgcn_readfirstlane((int)F.MISC[22]);
        if (t >= last) break;
#if MOE_FP8 && CONV_BLOCK2x4
        {
            int it; const int w = F.wave;
            if (t < NE * 128) { const int e = t >> 7, blk = t & 127, kb = 2 * (blk >> 4) + (w >> 2), nb = 4 * (blk & 15) + (w & 3); it = e * 1024 + kb * 64 + nb; }
            else { const int t2 = t - NE * 128, e = t2 >> 6, blk = t2 & 63, kb = 2 * (blk >> 3) + (w >> 2), nb = 4 * (blk & 7) + (w & 3); it = NE * 1024 + e * 512 + kb * 32 + nb; }
            p0_expert_item(F, it); }
#else
        p0_expert_item(F, t * NWAVES + F.wave);
#endif
    }
    __syncthreads();
}
__device__ __forceinline__ void p1_meta_rows(Frame& F) {
    int lane = lane_id(); asm volatile("" : "+v"(lane));
    const int gw = F.vcu * NWAVES + F.wave;
    if (gw >= 224) return;
    const bf16* U = (const bf16*)(F.ws + WS_U); const bf16* W = (const bf16*)(F.ws + WS_WIN); bf16* Z = (bf16*)(F.ws + WS_Z);
    const int col0 = gw < 32 ? C_RK + 16 * gw : gw < 96 ? C_RV + 16 * (gw - 32) : C_DK + 16 * (gw - 96);
    const bf16* ap = U + (size_t)(T + (lane & 15)) * DM + 8 * (lane >> 4);
    const bf16* bp = W + (size_t)(col0 + (lane & 15)) * DM + 8 * (lane >> 4);
    f32x4 acc = (f32x4){0.f, 0.f, 0.f, 0.f};
#pragma unroll 8
    for (int st = 0; st < DM / 32; ++st) { const bf16x8 a = *(const GAS bf16x8*)(ap + 32 * st), b = *(const GAS bf16x8*)(bp + 32 * st);
        acc = __builtin_amdgcn_mfma_f32_16x16x32_bf16(a, b, acc, 0, 0, 0); }
    if (gw >= 96 && gw < 160) {
        LAS float* SSQ = (LAS float*)F.lds;
        float s4[4];
#pragma unroll
        for (int r = 0; r < 4; ++r) s4[r] = red16(acc[r] * acc[r]);
        if ((lane & 15) == 0) {
#pragma unroll
            for (int r = 0; r < 4; ++r) SSQ[F.wave * 16 + 4 * (lane >> 4) + r] = s4[r]; }
        __syncthreads();
        const float g = F.in[IN_KG][(col0 - C_DK + (lane & 15)) & 127];
#pragma unroll
        for (int r = 0; r < 4; ++r) { float t = 0.f;
#pragma unroll
            for (int w = 0; w < NWAVES; ++w) t += SSQ[w * 16 + 4 * (lane >> 4) + r];
            const float rstd = 1.f / sqrtf(t * (1.f / 128.f) + EPS);
            Z[(size_t)(T + 4 * (lane >> 4) + r) * NIN + col0 + (lane & 15)] = (bf16)f2bf(acc[r] * rstd * g); }
        __syncthreads();
        return;
    }
    const float sc = gw < 32 ? 0.08838834764831845f : 1.f;
#pragma unroll
    for (int r = 0; r < 4; ++r) Z[(size_t)(T + 4 * (lane >> 4) + r) * NIN + col0 + (lane & 15)] = (bf16)f2bf(acc[r] * sc);
}

struct DenseSched {
    const bf16* A; const bf16* Bt; int nM, nN, pitch, G, c;
    __device__ __forceinline__ bool next(int i, pg8::Unit& u) const { u.e = 0; return pg8::order_next(i, G, c, nM, nN, u.pm, u.pn); }
    __device__ __forceinline__ const char* a_base(const pg8::Unit& u) const { return (const char*)A + (size_t)u.pm * 256 * pitch; }
    __device__ __forceinline__ const char* b_base(const pg8::Unit& u) const { return (const char*)Bt + (size_t)u.pn * 256 * pitch; }
    __device__ __forceinline__ void a_off(const pg8::Unit&, int, unsigned (&)[4]) const {}
    __device__ __forceinline__ bool skip_hi(const pg8::Unit&) const { return false; }
    __device__ __forceinline__ void a_tok_dma(const pg8::Unit&, LAS unsigned char*, int, int) const {}
    __device__ __forceinline__ void a_off_lds(LAS unsigned char*, int, unsigned (&)[4]) const {}
};
struct QueueSched {
    const bf16* A; const bf16* Bt; int nQ, nN, pitch, q0; gu32* cnt; volatile LAS int* slot;
    __device__ __forceinline__ bool next(int i, pg8::Unit& u) const {
        const int per_q = 8 * nN;
        if (threadIdx.x == 0) { int L = -1;
            { const unsigned t = __hip_atomic_fetch_add(cnt + 64 * q0, 1u, __ATOMIC_RELAXED, __HIP_MEMORY_SCOPE_AGENT); if (t < (unsigned)per_q) L = q0 * per_q + (int)t; }
            if (L < 0) {
                unsigned c[8];
#pragma unroll
                for (int k = 1; k < 8; ++k) c[k] = k < nQ ? __hip_atomic_load(cnt + 64 * ((q0 + k) % nQ), __ATOMIC_RELAXED, __HIP_MEMORY_SCOPE_AGENT) : 0xffffffffu;
#pragma unroll
                for (int k = 1; k < 8; ++k) if (L < 0 && c[k] < (unsigned)per_q) { const int q = (q0 + k) % nQ;
                    const unsigned t = __hip_atomic_fetch_add(cnt + 64 * q, 1u, __ATOMIC_RELAXED, __HIP_MEMORY_SCOPE_AGENT); if (t < (unsigned)per_q) L = q * per_q + (int)t; }
            }
            slot[i & 1] = L; }
        asm volatile("s_waitcnt lgkmcnt(0)" ::: "memory"); __builtin_amdgcn_s_barrier(); asm volatile("" ::: "memory");
        const int L = __builtin_amdgcn_readfirstlane(slot[i & 1]);
        if (L < 0) return false;
        const int q = L / per_q, t = L % per_q; u.pm = 8 * q + (t & 7); u.pn = t >> 3; u.e = 0; return true; }
    __device__ __forceinline__ const char* a_base(const pg8::Unit& u) const { return (const char*)A + (size_t)u.pm * 256 * pitch; }
    __device__ __forceinline__ const char* b_base(const pg8::Unit& u) const { return (const char*)Bt + (size_t)u.pn * 256 * pitch; }
    __device__ __forceinline__ void a_off(const pg8::Unit&, int, unsigned (&)[4]) const {}
    __device__ __forceinline__ bool skip_hi(const pg8::Unit&) const { return false; }
    __device__ __forceinline__ void a_tok_dma(const pg8::Unit&, LAS unsigned char*, int, int) const {}
    __device__ __forceinline__ void a_off_lds(LAS unsigned char*, int, unsigned (&)[4]) const {}
};
struct EpiZ {
    static constexpr bool PERM = true; static constexpr int ID = 1;
    bf16* Z; const float* qg; const float* kg; LAS float* P;
    __device__ __forceinline__ void prefetch(const pg8::Unit&, LAS unsigned char*, int, int) const {}
    __device__ __forceinline__ void operator()(const f32x4 (&acc)[2][2][4][2], const pg8::Unit& u, int wr, int wc, int fr, int fq) const {
        const int row0 = u.pm * 256 + wr * 64 + fr, col0 = u.pn * 256 + wc * 32 + 8 * fq;
        if (u.pn >= 12 && u.pn < 20) {
            const float* gp = (u.pn < 16 ? qg : kg) + wc * 32 + 8 * fq; const float gs = u.pn < 16 ? 0.08838834764831845f : 1.f;
            const f32x4 g0 = *(const f32x4*)gp * gs, g1 = *(const f32x4*)(gp + 4) * gs;
#pragma unroll
            for (int ai = 0; ai < 2; ++ai)
#pragma unroll
                for (int m = 0; m < 4; ++m)
#pragma unroll
                    for (int bj = 0; bj < 2; ++bj) { const f32x4 a = acc[ai][bj][m][0], b = acc[ai][bj][m][1];
                        float sq = (a[0] * a[0] + a[1] * a[1]) + (a[2] * a[2] + a[3] * a[3]) + (b[0] * b[0] + b[1] * b[1]) + (b[2] * b[2] + b[3] * b[3]);
                        sq = red_x32(red_x16(sq));
                        if (fq == 0) P[(ai * 128 + wr * 64 + m * 16 + fr) * 8 + bj * 4 + wc] = sq; }
            asm volatile("s_waitcnt lgkmcnt(0)" ::: "memory"); __builtin_amdgcn_s_barrier(); asm volatile("" ::: "memory");
#pragma unroll
            for (int ai = 0; ai < 2; ++ai)
#pragma unroll
                for (int m = 0; m < 4; ++m) { bf16* rowp = Z + (size_t)(row0 + ai * 128 + m * 16) * NIN + col0;
#pragma unroll
                    for (int bj = 0; bj < 2; ++bj) { const f32x4 pp = *(const LAS f32x4*)(P + (ai * 128 + wr * 64 + m * 16 + fr) * 8 + bj * 4);
                        const float rstd = __builtin_amdgcn_rsqf(((pp[0] + pp[1]) + (pp[2] + pp[3])) * (1.f / 128.f) + EPS);
                        const f32x4 v0 = acc[ai][bj][m][0] * g0 * rstd, v1 = acc[ai][bj][m][1] * g1 * rstd;
                        v4u w; w.x = cvtpk(v0[0], v0[1]); w.y = cvtpk(v0[2], v0[3]); w.z = cvtpk(v1[0], v1[1]); w.w = cvtpk(v1[2], v1[3]);
                        *(v4u*)(rowp + bj * 128) = w; } }
            return;
        }
        const float s = (u.pn == 2 || u.pn == 3) ? 0.08838834764831845f : 1.f;
#pragma unroll
        for (int ai = 0; ai < 2; ++ai)
#pragma unroll
            for (int m = 0; m < 4; ++m) { bf16* rowp = Z + (size_t)(row0 + ai * 128 + m * 16) * NIN + col0;
#pragma unroll
                for (int bj = 0; bj < 2; ++bj) { const f32x4 v0 = acc[ai][bj][m][0] * s, v1 = acc[ai][bj][m][1] * s;
                    v4u w; w.x = cvtpk(v0[0], v0[1]); w.y = cvtpk(v0[2], v0[3]); w.z = cvtpk(v1[0], v1[1]); w.w = cvtpk(v1[2], v1[3]);
                    *(v4u*)(rowp + bj * 128) = w; } }
    }
};
struct EpiOut {
    static constexpr bool PERM = true; static constexpr int ID = 2;
    const float* X; bf16* H;
    __device__ __forceinline__ void prefetch(const pg8::Unit&, LAS unsigned char*, int, int) const {}
    __device__ __forceinline__ void operator()(const f32x4 (&acc)[2][2][4][2], const pg8::Unit& u, int wr, int wc, int fr, int fq) const {
        const int row0 = u.pm * 256 + wr * 64 + fr, col0 = u.pn * 256 + wc * 32 + 8 * fq;
#pragma unroll
        for (int ai = 0; ai < 2; ++ai) {
            f32x4 xv[4][2][2];
#pragma unroll
            for (int m = 0; m < 4; ++m) { const size_t off = (size_t)(row0 + ai * 128 + m * 16) * DM + col0;
#pragma unroll
                for (int bj = 0; bj < 2; ++bj)
#pragma unroll
                    for (int n = 0; n < 2; ++n) xv[m][bj][n] = *(const f32x4*)(X + off + bj * 128 + n * 4); }
            asm volatile("" ::: "memory");
#pragma unroll
            for (int m = 0; m < 4; ++m) { const size_t off = (size_t)(row0 + ai * 128 + m * 16) * DM + col0;
#pragma unroll
                for (int bj = 0; bj < 2; ++bj) { const f32x4 v0 = acc[ai][bj][m][0] + xv[m][bj][0], v1 = acc[ai][bj][m][1] + xv[m][bj][1];
                    v4u w; w.x = cvtpk(v0[0], v0[1]); w.y = cvtpk(v0[2], v0[3]); w.z = cvtpk(v1[0], v1[1]); w.w = cvtpk(v1[2], v1[3]);
                    *(v4u*)(H + off + bj * 128) = w; } }
            asm volatile("" ::: "memory"); }
    }
};
struct MoeTab { LAS int* cnt; LAS int* rbase; LAS int* tile_e; LAS int* tile_r0; LAS int* ntiles; };
__device__ __forceinline__ MoeTab moe_tab(Frame& F) {
    MoeTab t; LAS int* p = (LAS int*)(F.lds + TAB_OFF);
    t.cnt = p; t.rbase = p + 32; t.ntiles = p + 64; t.tile_e = p + 128; t.tile_r0 = p + 128 + 320; return t;
}
__device__ __forceinline__ void moe_build_tables(Frame& F) {
    MoeTab t = moe_tab(F);
    __syncthreads();
    if (F.tid < NE) { int c = (int)__hip_atomic_load(F.ctl + CW_CNT + 64 * F.tid, __ATOMIC_RELAXED, __HIP_MEMORY_SCOPE_AGENT); if (c > ECAP) c = ECAP; if (c < 0) c = 0; t.cnt[F.tid] = c; }
    __syncthreads();
    if (F.tid < NE) {
        const int e = F.tid; int nt = 0;
#pragma unroll 8
        for (int i = 0; i < NE; ++i) nt += i < e ? (t.cnt[i] + 255) >> 8 : 0;
        const int k = (t.cnt[e] + 255) >> 8; t.rbase[e] = nt * 256;
        for (int j = 0; j < k; ++j) { t.tile_e[nt + j] = e; t.tile_r0[nt + j] = j * 256; }
        if (e == NE - 1) t.ntiles[0] = nt + k;
    }
    __syncthreads();
}
struct MoeSched {
    const unsigned char* A; const unsigned char* Wt; size_t wstride_bytes; int nN, pitch, G, c; MoeTab tb; const int* tok;
    __device__ __forceinline__ bool next(int i, pg8::Unit& u) const {
        const int nM = tb.ntiles[0]; int pm, pn; if (!pg8::order_next(i, G, c, nM, nN, pm, pn)) return false;
        u.pm = pm; u.pn = pn; u.e = __builtin_amdgcn_readfirstlane(tb.tile_e[pm]); return true; }
    __device__ __forceinline__ const char* a_base(const pg8::Unit& u) const { return tok ? (const char*)A : (const char*)A + (size_t)u.pm * 256 * pitch; }
    __device__ __forceinline__ const char* b_base(const pg8::Unit& u) const { return (const char*)Wt + (size_t)u.e * wstride_bytes + (size_t)u.pn * 256 * pitch; }
    __device__ __forceinline__ bool skip_hi(const pg8::Unit& u) const { return __builtin_amdgcn_readfirstlane(tb.cnt[u.e] - tb.tile_r0[u.pm]) <= 128; }
    __device__ __forceinline__ void a_tok(const pg8::Unit& u, int tid, int (&tk)[4]) const {
        const int r0 = tb.tile_r0[u.pm], cn = tb.cnt[u.e];
#pragma unroll
        for (int i = 0; i < 2; ++i) { int R, C; pg8::stage_rc(tid * 16 + i * 8192, R, C);
#pragma unroll
            for (int h = 0; h < 2; ++h) { const int rl = r0 + h * 128 + R; tk[2 * h + i] = tok[(size_t)u.e * ECAP + (rl < cn ? rl : 0)] * (rl < cn ? 1 : 0); } }
    }
    __device__ __forceinline__ void a_off_tok(const int (&tk)[4], int tid, unsigned (&vo)[4]) const {
#pragma unroll
        for (int i = 0; i < 2; ++i) { int R, C; pg8::stage_rc(tid * 16 + i * 8192, R, C);
#pragma unroll
            for (int h = 0; h < 2; ++h) vo[2 * h + i] = (unsigned)tk[2 * h + i] * (unsigned)pitch + (unsigned)C * 2u; }
    }
    __device__ __forceinline__ void a_off(const pg8::Unit& u, int tid, unsigned (&vo)[4]) const { int tk[4]; a_tok(u, tid, tk); a_off_tok(tk, tid, vo); }
    __device__ __forceinline__ void a_tok_dma(const pg8::Unit& u, LAS unsigned char* lds, int wid, int lane) const {
        if (wid < 4) { const int rl = tb.tile_r0[u.pm] + wid * 64 + lane;
            __builtin_amdgcn_global_load_lds((const unsigned*)(tok + (size_t)u.e * ECAP + (rl < tb.cnt[u.e] ? rl : 0)), (LAS unsigned*)(lds + EPF_OFF + 2048) + wid * 64, 4, 0, 0); }
    }
    __device__ __forceinline__ void a_off_lds(LAS unsigned char* lds, int tid, unsigned (&vo)[4]) const {
        const LAS int* TK = (const LAS int*)(lds + EPF_OFF + 2048);
#pragma unroll
        for (int i = 0; i < 2; ++i) { int R, C; pg8::stage_rc(tid * 16 + i * 8192, R, C);
#pragma unroll
            for (int h = 0; h < 2; ++h) vo[2 * h + i] = (unsigned)TK[h * 128 + R] * (unsigned)pitch + (unsigned)C * 2u; }
    }
};
struct EpiAct {
    static constexpr bool PERM = true; static constexpr int ID = 4;
    unsigned char* ACT; const float* bgu; const float* rs; MoeTab tb; LAS unsigned char* lds;
    __device__ __forceinline__ void prefetch(const pg8::Unit& u, LAS unsigned char* lds, int wid, int lane) const {
        LAS unsigned* P = (LAS unsigned*)(lds + EPF_OFF) + wid * 64;
        const float* src;
        if (wid < 4) { const int rl = tb.tile_r0[u.pm] + wid * 64 + lane; src = rs + (size_t)u.e * ECAP + (rl < tb.cnt[u.e] ? rl : 0); }
        else { const int idx = (wid - 4) * 64 + lane; src = bgu + (size_t)u.e * 4096 + u.pn * 128 + (idx & 127) + (idx >> 7) * 2048; }
        __builtin_amdgcn_global_load_lds((const unsigned*)src, P, 4, 0, 0);
    }
    __device__ __forceinline__ void operator()(const f32x4 (&acc)[2][2][4][2], const pg8::Unit& u, int wr, int wc, int fr, int fq) const {
        const int lrow0 = wr * 64 + fr, col0 = u.pn * 128 + wc * 32 + 8 * fq;
        const int r0 = tb.tile_r0[u.pm], cn = tb.cnt[u.e];
        const LAS float* PF = (const LAS float*)(lds + EPF_OFF);
        const LAS float* bg = PF + 256 + wc * 32 + 8 * fq;
        const f32x4 g0 = *(const LAS f32x4*)bg, g1 = *(const LAS f32x4*)(bg + 4), u0 = *(const LAS f32x4*)(bg + 128), u1 = *(const LAS f32x4*)(bg + 132);
        float sv[2][4];
#pragma unroll
        for (int ai = 0; ai < 2; ++ai)
#pragma unroll
            for (int m = 0; m < 4; ++m) { const int rl = r0 + lrow0 + ai * 128 + m * 16; sv[ai][m] = PF[lrow0 + ai * 128 + m * 16] * (rl < cn ? 1.f : 0.f); }
        constexpr float us = MOE_FP8 ? 1.f / (FP8_SX * FP8_SW) : 1.f;
        constexpr float CG = -1.702f * 1.4426950408889634f, SA = MOE_FP8 ? FP8_SA : 1.f, KI = CG / SA;
        const f32x4 g0c = g0 * CG, g1c = g1 * CG, u0p = u0 + 1.f, u1p = u1 + 1.f;
#pragma unroll
        for (int ai = 0; ai < 2; ++ai)
#pragma unroll
            for (int m = 0; m < 4; ++m) { const int lr = lrow0 + ai * 128 + m * 16;
                const float s = sv[ai][m] * us, sc = s * CG;
                f32x4 o4[2];
#pragma unroll
                for (int n = 0; n < 2; ++n) { f32x4 t = acc[ai][0][m][n] * sc + (n ? g1c : g0c), up = acc[ai][1][m][n] * s + (n ? u1p : u0p), r;
#pragma unroll
                    for (int j = 0; j < 4; ++j) { t[j] = fmaxf(t[j], 7.f * CG); up[j] = __builtin_amdgcn_fmed3f(up[j], -6.f, 8.f);
                        r[j] = __builtin_amdgcn_rcpf(__builtin_fmaf(__builtin_amdgcn_exp2f(t[j]), KI, KI)); }
                    o4[n] = up * t * r; }
#if MOE_FP8
                unsigned w0 = 0, w1 = 0;
                w0 = __builtin_amdgcn_cvt_pk_fp8_f32(o4[0][0], o4[0][1], w0, false); w0 = __builtin_amdgcn_cvt_pk_fp8_f32(o4[0][2], o4[0][3], w0, true);
                w1 = __builtin_amdgcn_cvt_pk_fp8_f32(o4[1][0], o4[1][1], w1, false); w1 = __builtin_amdgcn_cvt_pk_fp8_f32(o4[1][2], o4[1][3], w1, true);
                v2u w; w.x = w0; w.y = w1;
                *(v2u*)(ACT + (size_t)(u.pm * 256 + lr) * DFF + col0) = w; }
#else
                v4u w; w.x = cvtpk(o4[0][0], o4[0][1]); w.y = cvtpk(o4[0][2], o4[0][3]); w.z = cvtpk(o4[1][0], o4[1][1]); w.w = cvtpk(o4[1][2], o4[1][3]);
                *(v4u*)(ACT + ((size_t)(u.pm * 256 + lr) * DFF + col0) * 2) = w; }
#endif
    }
};
struct EpiY {
    static constexpr bool PERM = true; static constexpr int ID = 8;
    unsigned char* Y; const float* bd; const float* gate; MoeTab tb; LAS unsigned char* lds;
    __device__ __forceinline__ void prefetch(const pg8::Unit& u, LAS unsigned char* lds, int wid, int lane) const {
        LAS unsigned* P = (LAS unsigned*)(lds + EPF_OFF) + wid * 64;
        const float* src;
        if (wid < 4) { const int rl = tb.tile_r0[u.pm] + wid * 64 + lane; src = gate + (size_t)u.e * ECAP + (rl < tb.cnt[u.e] ? rl : 0); }
        else src = bd + (size_t)u.e * DM + u.pn * 256 + (wid - 4) * 64 + lane;
        __builtin_amdgcn_global_load_lds((const unsigned*)src, P, 4, 0, 0);
    }
    __device__ __forceinline__ void operator()(const f32x4 (&acc)[2][2][4][2], const pg8::Unit& u, int wr, int wc, int fr, int fq) const {
        const int lrow0 = wr * 64 + fr, col0 = u.pn * 256 + wc * 32 + 8 * fq;
        const int r0 = tb.tile_r0[u.pm], cn = tb.cnt[u.e];
        const LAS float* PF = (const LAS float*)(lds + EPF_OFF);
        const LAS float* bp = PF + 256 + wc * 32 + 8 * fq;
        f32x4 bv[2][2];
#pragma unroll
        for (int bj = 0; bj < 2; ++bj) { bv[bj][0] = *(const LAS f32x4*)(bp + bj * 128); bv[bj][1] = *(const LAS f32x4*)(bp + bj * 128 + 4); }
        float gv[2][4];
#pragma unroll
        for (int ai = 0; ai < 2; ++ai)
#pragma unroll
            for (int m = 0; m < 4; ++m) { const int rl = r0 + lrow0 + ai * 128 + m * 16; gv[ai][m] = PF[lrow0 + ai * 128 + m * 16] * (rl < cn ? 1.f : 0.f); }
#pragma unroll
        for (int ai = 0; ai < 2; ++ai)
#pragma unroll
            for (int m = 0; m < 4; ++m) { const int lr = lrow0 + ai * 128 + m * 16;
                const float g = gv[ai][m];
                const size_t ro = (size_t)(u.pm * 256 + lr) * DM + col0;
#pragma unroll
                for (int bj = 0; bj < 2; ++bj) { constexpr float us = MOE_FP8 ? 1.f / (FP8_SA * FP8_SW) : 1.f;
#if Y_FP8
                    const float gs = g * FP8_SY; const f32x4 v0 = (acc[ai][bj][m][0] * us + bv[bj][0]) * gs, v1 = (acc[ai][bj][m][1] * us + bv[bj][1]) * gs;
                    v2u w; w.x = pk4_fp8(v0[0], v0[1], v0[2], v0[3]); w.y = pk4_fp8(v1[0], v1[1], v1[2], v1[3]);
                    *(v2u*)(Y + ro + bj * 128) = w; } }
#else
                    const f32x4 v0 = (acc[ai][bj][m][0] * us + bv[bj][0]) * g, v1 = (acc[ai][bj][m][1] * us + bv[bj][1]) * g;
                    v4u w; w.x = cvtpk(v0[0], v0[1]); w.y = cvtpk(v0[2], v0[3]); w.z = cvtpk(v1[0], v1[1]); w.w = cvtpk(v1[2], v1[3]);
                    *(v4u*)(Y + (ro + bj * 128) * 2) = w; } }
#endif
    }
};

template <int MI, int NI>
__device__ __forceinline__ void lds_mma(f32x16 (&acc)[MI][NI], const LAS bf16* A, int lda, const LAS bf16* B, int ldb, int K, int lane) {
    const int r = lane & 31, h = lane >> 5;
#pragma unroll 2
    for (int k0 = 0; k0 < K; k0 += 16) {
        bf16x8 a[MI], b[NI];
#pragma unroll
        for (int mi = 0; mi < MI; ++mi) a[mi] = *(const LAS bf16x8*)(A + (32 * mi + r) * lda + k0 + 8 * h);
#pragma unroll
        for (int ni = 0; ni < NI; ++ni) b[ni] = *(const LAS bf16x8*)(B + (32 * ni + r) * ldb + k0 + 8 * h);
#pragma unroll
        for (int mi = 0; mi < MI; ++mi)
#pragma unroll
            for (int ni = 0; ni < NI; ++ni) acc[mi][ni] = __builtin_amdgcn_mfma_f32_32x32x16_bf16(a[mi], b[ni], acc[mi][ni], 0, 0, 0);
    }
}
constexpr int LDP = 136;
constexpr int LDO_T = 260;

__device__ __forceinline__ float log2_gamma(float p) { return log2f(1.f - exp2f(-p)); }

__device__ __forceinline__ void p2_fixup(Frame& F) {
    bf16* Z = (bf16*)(F.ws + WS_Z);
    int lane = lane_id(); asm volatile("" : "+v"(lane));
    const int gw = F.vcu * NWAVES + F.wave, NGW = F.G * NWAVES;
    float gq[8], gk[8];
#pragma unroll
    for (int e = 0; e < 8; ++e) { const int d = (8 * lane + e) & 127; gq[e] = F.in[IN_QG][d] * 0.08838834764831845f; gk[e] = F.in[IN_KG][d]; }
    for (int m = T + gw; m < T + NMETA; m += NGW) {
        GAS v4u* p = (GAS v4u*)(Z + (size_t)m * NIN + C_DQ) + lane;
        v4u w[4];
#pragma unroll
        for (int j = 0; j < 4; ++j) w[j] = p[64 * j];
#pragma unroll
        for (int j = 0; j < 4; ++j) {
            float v[8]; v[0] = bflo(w[j].x); v[1] = bfhi(w[j].x); v[2] = bflo(w[j].y); v[3] = bfhi(w[j].y); v[4] = bflo(w[j].z); v[5] = bfhi(w[j].z); v[6] = bflo(w[j].w); v[7] = bfhi(w[j].w);
            float s = 0.f;
#pragma unroll
            for (int e = 0; e < 8; ++e) s += v[e] * v[e];
            s = red16(s);
            const float rstd = 1.f / sqrtf(s * (1.f / 128.f) + EPS);
            v4u o;
            if (j < 2) { o.x = pk2(v[0] * rstd * gq[0], v[1] * rstd * gq[1]); o.y = pk2(v[2] * rstd * gq[2], v[3] * rstd * gq[3]); o.z = pk2(v[4] * rstd * gq[4], v[5] * rstd * gq[5]); o.w = pk2(v[6] * rstd * gq[6], v[7] * rstd * gq[7]); }
            else       { o.x = pk2(v[0] * rstd * gk[0], v[1] * rstd * gk[1]); o.y = pk2(v[2] * rstd * gk[2], v[3] * rstd * gk[3]); o.z = pk2(v[4] * rstd * gk[4], v[5] * rstd * gk[5]); o.w = pk2(v[6] * rstd * gk[6], v[7] * rstd * gk[7]); }
            p[64 * j] = o;
        }
    }
}
template <int NC>
__device__ __forceinline__ void stage_transposed(LAS bf16* dst, const bf16* src, int tid) {
    const int j = tid >> 2, part = tid & 3; constexpr int PER = NC / 4;
    const bf16* s = src + (size_t)j * NIN + part * PER;
#pragma unroll
    for (int q = 0; q < PER / 8; ++q) { const v4u w = *(const GAS v4u*)(s + 8 * q); const int c0 = part * PER + 8 * q;
        dst[(c0 + 0) * LDP + j] = (bf16)(w.x & 0xffffu); dst[(c0 + 1) * LDP + j] = (bf16)(w.x >> 16);
        dst[(c0 + 2) * LDP + j] = (bf16)(w.y & 0xffffu); dst[(c0 + 3) * LDP + j] = (bf16)(w.y >> 16);
        dst[(c0 + 4) * LDP + j] = (bf16)(w.z & 0xffffu); dst[(c0 + 5) * LDP + j] = (bf16)(w.z >> 16);
        dst[(c0 + 6) * LDP + j] = (bf16)(w.w & 0xffffu); dst[(c0 + 7) * LDP + j] = (bf16)(w.w >> 16); }
}
__device__ __forceinline__ void p2_kvstates(Frame& F) {
    const bf16* Z = (const bf16*)(F.ws + WS_Z);
    bf16* KVS = (bf16*)(F.ws + WS_KVS); bf16* META = (bf16*)(F.ws + WS_META);
    LAS bf16* Vt = (LAS bf16*)F.lds;
    LAS bf16* Kt = (LAS bf16*)(F.lds + 256 * LDP * 2);
    for (int u = F.vcu; u < 16 * 32 + 4; u += F.G) {
        int tid = F.tid, wid = F.wave; asm volatile("" : "+v"(tid)); asm volatile("" : "+s"(wid));
        const int lane = tid & 63, we = wid >> 1, wd = wid & 1;
        const bool meta = u >= 512;
        const int bh = meta ? 0 : u >> 5, c = meta ? 0 : u & 31, b = bh >> 2, h = meta ? (u - 512) : (bh & 3);
        const size_t row0 = meta ? (size_t)T : (size_t)b * SEQ + 128 * c;
        const float lgf = log2_gamma(F.in[IN_DECF][h]), lgb = log2_gamma(F.in[IN_DECB][h]);
        __syncthreads();
        stage_transposed<256>(Vt, Z + row0 * NIN + C_RV + 256 * h, tid);
        const int j = tid >> 2, part = tid & 3;
        v4u kw[4];
#pragma unroll
        for (int q = 0; q < 4; ++q) kw[q] = *(const GAS v4u*)(Z + (row0 + j) * NIN + C_RK + 128 * h + 32 * part + 8 * q);
        for (int dir = 0; dir < (meta ? 1 : 2); ++dir) {
            float dec;
            if (meta) dec = (j < NMETA) ? exp2f(lgf * (float)(NMETA - 1 - j)) : 0.f;
            else dec = dir == 0 ? exp2f(lgf * (float)(127 - j)) : exp2f(lgb * (float)j);
            if (dir == 1) __syncthreads();
#pragma unroll
            for (int q = 0; q < 4; ++q) { const int d0 = 32 * part + 8 * q; const unsigned ww[4] = {kw[q].x, kw[q].y, kw[q].z, kw[q].w};
#pragma unroll
                for (int e = 0; e < 4; ++e) { Kt[(d0 + 2 * e) * LDP + j] = (bf16)f2bf(bflo(ww[e]) * dec); Kt[(d0 + 2 * e + 1) * LDP + j] = (bf16)f2bf(bfhi(ww[e]) * dec); } }
            __syncthreads();
            f32x16 acc[2][2];
#pragma unroll
            for (int a = 0; a < 2; ++a)
#pragma unroll
                for (int bb = 0; bb < 2; ++bb) acc[a][bb] = (f32x16){};
            lds_mma<2, 2>(acc, Vt + (64 * we) * LDP, LDP, Kt + (64 * wd) * LDP, LDP, 128, lane);
            bf16* dst = meta ? META + (size_t)h * 32768 : KVS + ((size_t)(bh * 2 + dir) * 32 + c) * 32768;
#pragma unroll
            for (int mi = 0; mi < 2; ++mi)
#pragma unroll
                for (int ni = 0; ni < 2; ++ni)
#pragma unroll
                    for (int r = 0; r < 16; ++r) dst[(64 * we + 32 * mi + crow(r, lane >> 5)) * 128 + 64 * wd + 32 * ni + (lane & 31)] = (bf16)f2bf(acc[mi][ni][r]);
        }
    }
    __syncthreads();
}

__device__ __forceinline__ void p3_scan(Frame& F) {
    bf16* KVS = (bf16*)(F.ws + WS_KVS); const bf16* META = (const bf16*)(F.ws + WS_META);
    int tid_ = F.tid; asm volatile("" : "+v"(tid_));
    int gt = F.vcu * 512 + tid_, NT_ = F.G * 512;
#if ATT_V2
    if ((F.G & 31) == 0) { const int sl = F.vcu & 31, q = sl & 15; if (q < 4 || q >= 12) return; gt = (((F.vcu >> 5) * 16 + (sl >> 4) * 8 + (q - 4)) * 512) + tid_; NT_ = (F.G >> 1) * 512; }
#endif
    for (int it = gt; it < 16 * 2 * 256 * 16; it += NT_) {
        const int d8 = it & 15, e = (it >> 4) & 255, dir = (it >> 12) & 1, bh = it >> 13, h = bh & 3;
        const float lg = log2_gamma(dir == 0 ? F.in[IN_DECF][h] : F.in[IN_DECB][h]);
        const float g128 = exp2f(lg * 128.f);
        GAS v4u* p = (GAS v4u*)(KVS + (size_t)(bh * 2 + dir) * 32 * 32768 + e * 128 + d8 * 8);
        float s[8];
        if (dir == 0) { const v4u a = *(const GAS v4u*)(META + (size_t)h * 32768 + e * 128 + d8 * 8);
            s[0] = bflo(a.x); s[1] = bfhi(a.x); s[2] = bflo(a.y); s[3] = bfhi(a.y); s[4] = bflo(a.z); s[5] = bfhi(a.z); s[6] = bflo(a.w); s[7] = bfhi(a.w); }
        else {
#pragma unroll
            for (int k = 0; k < 8; ++k) s[k] = 0.f; }
#pragma unroll
        for (int half = 0; half < 2; ++half) {
            v4u t[16];
#pragma unroll
            for (int i = 0; i < 16; ++i) { const int c = dir == 0 ? (half * 16 + i) : (31 - half * 16 - i); t[i] = p[(size_t)c * 4096]; }
#pragma unroll
            for (int i = 0; i < 16; ++i) { const int c = dir == 0 ? (half * 16 + i) : (31 - half * 16 - i);
                v4u o; o.x = pk2(s[0], s[1]); o.y = pk2(s[2], s[3]); o.z = pk2(s[4], s[5]); o.w = pk2(s[6], s[7]); p[(size_t)c * 4096] = o;
                s[0] = s[0] * g128 + bflo(t[i].x); s[1] = s[1] * g128 + bfhi(t[i].x); s[2] = s[2] * g128 + bflo(t[i].y); s[3] = s[3] * g128 + bfhi(t[i].y);
                s[4] = s[4] * g128 + bflo(t[i].z); s[5] = s[5] * g128 + bfhi(t[i].z); s[6] = s[6] * g128 + bflo(t[i].w); s[7] = s[7] * g128 + bfhi(t[i].w); }
        }
    }
}

namespace att {
constexpr int D = 128, NW = 8, QBLK = 32, KVBLK = 64, NT = 65;
constexpr float THR = 8.f;
constexpr int LDK = NIN, LDO = 2048;
constexpr size_t SHM_V = KVBLK * D * 2, SHM_K = KVBLK * D * 2, SHM_ATTN = 2 * SHM_V + 2 * SHM_K + NW * 64 * 4;
#define KSWZ(row, colB) ((row) * 256 + ((colB) ^ (((row) & 15) << 4)))
__device__ __forceinline__ void partialSM(f32x16& p0, f32x16& p1, float& m_reg, float& mn, float& alpha) {
    constexpr float C = 1.4426950408889634f;
    float pmax = p0[0];
#pragma unroll
    for (int r = 1; r < 16; ++r) pmax = fmaxf(pmax, p0[r]);
#pragma unroll
    for (int r = 0; r < 16; ++r) pmax = fmaxf(pmax, p1[r]);
    { auto rr = __builtin_amdgcn_permlane32_swap(__float_as_uint(pmax), __float_as_uint(pmax), false, false);
      pmax = fmaxf(__uint_as_float(rr[0]), __uint_as_float(rr[1])); }
    if (__builtin_expect(__all(pmax - m_reg <= THR), 1)) { mn = m_reg; alpha = 1.f; }
    else { mn = fmaxf(m_reg, pmax); alpha = __builtin_amdgcn_exp2f((m_reg - mn) * C); m_reg = mn; }
    const float mnC = -mn * C;
#pragma unroll
    for (int r = 0; r < 16; ++r) p0[r] = fmaf(p0[r], C, mnC);
#pragma unroll
    for (int r = 0; r < 16; ++r) p1[r] = fmaf(p1[r], C, mnC);
#pragma unroll
    for (int r = 0; r < 16; ++r) p0[r] = __builtin_amdgcn_exp2f(p0[r]);
}
__device__ __forceinline__ void finishSM(f32x16& p0, f32x16& p1, float alpha, float& l_reg, bf16x8& pa0, bf16x8& pa1, bf16x8& pa2, bf16x8& pa3) {
#pragma unroll
    for (int r = 0; r < 16; ++r) p1[r] = __builtin_amdgcn_exp2f(p1[r]);
    float ps = 0;
#pragma unroll
    for (int r = 0; r < 16; ++r) ps += p0[r];
#pragma unroll
    for (int r = 0; r < 16; ++r) ps += p1[r];
    { auto rr = __builtin_amdgcn_permlane32_swap(__float_as_uint(ps), __float_as_uint(ps), false, false);
      ps = __uint_as_float(rr[0]) + __uint_as_float(rr[1]); }
    l_reg = l_reg * alpha + ps;
#define PK4(P, BASE, OUT) do { unsigned a0 = cvtpk(P[BASE + 0], P[BASE + 1]), a1 = cvtpk(P[BASE + 2], P[BASE + 3]);   \
    unsigned b0 = cvtpk(P[BASE + 4], P[BASE + 5]), b1 = cvtpk(P[BASE + 6], P[BASE + 7]);                              \
    auto r0 = __builtin_amdgcn_permlane32_swap(a0, b0, false, false); auto r1 = __builtin_amdgcn_permlane32_swap(a1, b1, false, false); \
    v4u w = {r0[0], r1[0], r0[1], r1[1]}; OUT = *reinterpret_cast<bf16x8*>(&w); } while (0)
    PK4(p0, 0, pa0); PK4(p0, 8, pa1); PK4(p1, 0, pa2); PK4(p1, 8, pa3);
#undef PK4
}
__device__ __forceinline__ void qkt(f32x16& p0, f32x16& p1, const bf16* Ks, const bf16x8* qr, int r32, int hi, float dq, float nslope, int mode) {
    if (mode == 1) {
#pragma unroll
        for (int r = 0; r < 16; ++r) { p0[r] = r < 8 ? 0.f : -1e30f; p1[r] = -1e30f; }
    } else if (mode >= 2) {
        const float s1 = mode == 2 ? -nslope : nslope, a0 = -s1 * dq, a1 = a0 + 32.f * s1;
#pragma unroll
        for (int r = 0; r < 16; ++r) { const float c = (float)((r & 3) + 8 * (r >> 2)); p0[r] = fmaf(c, s1, a0); p1[r] = fmaf(c, s1, a1); }
    } else {
#pragma unroll
        for (int r = 0; r < 16; ++r) { const float c = (float)((r & 3) + 8 * (r >> 2)); p0[r] = nslope * fabsf(dq - c); p1[r] = nslope * fabsf(dq - 32.f - c); }
    }
#pragma unroll
    for (int d0 = 0; d0 < 8; ++d0) { const int cb = (d0 * 16 + hi * 8) * 2;
        const bf16x8 b0 = *reinterpret_cast<const bf16x8*>((const char*)Ks + KSWZ(r32, cb));
        const bf16x8 b1 = *reinterpret_cast<const bf16x8*>((const char*)Ks + KSWZ(32 + r32, cb));
        p0 = __builtin_amdgcn_mfma_f32_32x32x16_bf16(b0, qr[d0], p0, 0, 0, 0);
        p1 = __builtin_amdgcn_mfma_f32_32x32x16_bf16(b1, qr[d0], p1, 0, 0, 0); }
}
__device__ __forceinline__ int v_st(int k, int c) { const int kk = (k & ~0xC) | ((k & 4) << 1) | ((k & 8) >> 1); return ((kk >> 3) * 4 + (c >> 5)) * 512 + ((kk & 7) * 32 + (c & 31)) * 2; }
__device__ __forceinline__ int v_rd_base(int lane) { return ((lane & 3) << 3) | (((lane >> 2) & 3) << 6) | (((lane >> 4) & 1) << 5) | (((lane >> 5) & 1) << 8); }
constexpr int v_rd_off(int d0, int ks, int half) { return d0 * 512 + ks * 4096 + half * 2048; }
template <int OFF> __device__ __forceinline__ s16x4 tr_read(int vb) {
    s16x4 r; asm volatile("ds_read_b64_tr_b16 %0, %1 offset:%2" : "=&v"(r) : "v"(vb), "i"(OFF) : "memory"); return r;
}
template <int D0> __device__ __forceinline__ void pv_one(f32x16& od, int vb, bf16x8 pa0, bf16x8 pa1, bf16x8 pa2, bf16x8 pa3) {
    const s16x4 l0 = tr_read<v_rd_off(D0, 0, 0)>(vb), h0 = tr_read<v_rd_off(D0, 0, 1)>(vb), l1 = tr_read<v_rd_off(D0, 1, 0)>(vb), h1 = tr_read<v_rd_off(D0, 1, 1)>(vb);
    const s16x4 l2 = tr_read<v_rd_off(D0, 2, 0)>(vb), h2 = tr_read<v_rd_off(D0, 2, 1)>(vb), l3 = tr_read<v_rd_off(D0, 3, 0)>(vb), h3 = tr_read<v_rd_off(D0, 3, 1)>(vb);
    asm volatile("s_waitcnt lgkmcnt(0)" ::: "memory"); SBAR();
#define PK(L, H) (bf16x8){L[0], L[1], L[2], L[3], H[0], H[1], H[2], H[3]}
    od = __builtin_amdgcn_mfma_f32_32x32x16_bf16(pa0, PK(l0, h0), od, 0, 0, 0);
    od = __builtin_amdgcn_mfma_f32_32x32x16_bf16(pa1, PK(l1, h1), od, 0, 0, 0);
    od = __builtin_amdgcn_mfma_f32_32x32x16_bf16(pa2, PK(l2, h2), od, 0, 0, 0);
    od = __builtin_amdgcn_mfma_f32_32x32x16_bf16(pa3, PK(l3, h3), od, 0, 0, 0);
#undef PK
}
__device__ __forceinline__ void pv_d0(f32x16* o, int vb, bf16x8 pa0, bf16x8 pa1, bf16x8 pa2, bf16x8 pa3) {
    pv_one<0>(o[0], vb, pa0, pa1, pa2, pa3); pv_one<1>(o[1], vb, pa0, pa1, pa2, pa3); pv_one<2>(o[2], vb, pa0, pa1, pa2, pa3); pv_one<3>(o[3], vb, pa0, pa1, pa2, pa3);
}
__device__ __forceinline__ void attn_unit(const bf16* __restrict__ Zb, unsigned qoff, unsigned kreal, unsigned vreal, unsigned kmeta, unsigned vmeta,
                                          bf16* __restrict__ Ob, int q0, float nslope, int jlo, int nreal, char* lds) {
    const __amdgpu_buffer_rsrc_t rs = __builtin_amdgcn_make_buffer_rsrc((void*)Zb, 0, (int)((TM + 64) * (size_t)NIN * 2), 0x00020000);
    int tid = threadIdx.x; asm volatile("" : "+v"(tid));
    const int wid = tid >> 6, lane = tid & 63, r32 = lane & 31, hi = lane >> 5;
    bf16* V_lds = (bf16*)lds; bf16* K_lds = (bf16*)(lds + 2 * SHM_V);
    float* ws = (float*)(lds + 2 * SHM_V + 2 * SHM_K) + wid * 64; float* li_l = ws; float* al_l = ws + 32;
    float m_reg = -1e30f, l_reg = 0; f32x16 o[4] = {}; bf16x8 qr[8];
    { const unsigned qo = qoff + (unsigned)((wid * QBLK + r32) * LDK + hi * 8) * 2u;
#pragma unroll
      for (int d0 = 0; d0 < 8; ++d0) qr[d0] = __builtin_bit_cast(bf16x8, __builtin_amdgcn_raw_buffer_load_b128(rs, qo + (unsigned)(d0 * 32), 0, 0)); }
    const float qpos = (float)(q0 + wid * QBLK + r32 - 4 * hi);
    const int sr = tid >> 4, sc = (tid & 15) * 8, vst0 = v_st(sr, sc), vst1 = v_st(32 + sr, sc);
    const unsigned lvo = (unsigned)(sr * LDK + sc) * 2u;
    const int vb0 = (int)(uintptr_t)V_lds + v_rd_base(lane);
    struct { bf16x8 vs0, vs1, ks0, ks1; } sr_[1];
#define TI(p) ((p) < nreal ? jlo + (p) : 64)
#define SLOAD(i, jt) do { const unsigned ko_ = (jt) < 64 ? kreal + (unsigned)(jt) * (unsigned)(KVBLK * LDK * 2) : kmeta; const unsigned vo_ = (jt) < 64 ? vreal + (unsigned)(jt) * (unsigned)(KVBLK * LDK * 2) : vmeta; \
    sr_[i].vs0 = __builtin_bit_cast(bf16x8, __builtin_amdgcn_raw_buffer_load_b128(rs, lvo, vo_, 0)); sr_[i].vs1 = __builtin_bit_cast(bf16x8, __builtin_amdgcn_raw_buffer_load_b128(rs, lvo, vo_ + (unsigned)(32 * LDK * 2), 0)); \
    sr_[i].ks0 = __builtin_bit_cast(bf16x8, __builtin_amdgcn_raw_buffer_load_b128(rs, lvo, ko_, 0)); sr_[i].ks1 = __builtin_bit_cast(bf16x8, __builtin_amdgcn_raw_buffer_load_b128(rs, lvo, ko_ + (unsigned)(32 * LDK * 2), 0)); } while (0)
#define SWRITE(b, i) do { *(bf16x8*)((char*)V_lds + (b) * SHM_V + vst0) = sr_[i].vs0;          \
    *(bf16x8*)((char*)V_lds + (b) * SHM_V + vst1) = sr_[i].vs1; int kc = sc * 2;               \
    *(bf16x8*)((char*)K_lds + (b) * SHM_K + KSWZ(sr, kc)) = sr_[i].ks0;                       \
    *(bf16x8*)((char*)K_lds + (b) * SHM_K + KSWZ(32 + sr, kc)) = sr_[i].ks1; } while (0)
#define SWAIT() asm volatile("s_waitcnt vmcnt(0)" ::: "memory")
#define RESC(a) do { if (__any((a) < 1.f)) { if (hi == 0) al_l[r32] = (a); asm volatile("s_waitcnt lgkmcnt(0)" ::: "memory"); \
    _Pragma("unroll") for (int d = 0; d < 4; ++d) _Pragma("unroll") for (int r = 0; r < 16; ++r) o[d][r] *= al_l[crow(r, hi)]; } } while (0)
#define DQ(jt) (qpos - (float)((jt) * KVBLK))
    const int qmin = q0 + QBLK * __builtin_amdgcn_readfirstlane(wid);
#define MODE(jt) ((jt) * KVBLK + KVBLK - 1 <= qmin ? 2 : ((jt) * KVBLK >= qmin + QBLK - 1 ? 3 : 0))
    f32x16 pA0, pA1, pB0, pB1; float mnA, mnB, alA, alB; bf16x8 pa0, pa1, pa2, pa3;
    constexpr int SE = 0, SO = 0;
    const int NTu = nreal + 1;
    SLOAD(SE, jlo); asm volatile("s_waitcnt vmcnt(0)" ::: "memory"); SWRITE(0, SE); __syncthreads();
    qkt(pA0, pA1, K_lds, qr, r32, hi, DQ(jlo), nslope, MODE(jlo)); partialSM(pA0, pA1, m_reg, mnA, alA);
    SLOAD(SO, jlo + 1);
    SWAIT(); SWRITE(1, SO); __syncthreads();
    for (int p = 1; p + 1 < NTu; p += 2) {
        const int tq = TI(p + 1), tn = TI(p + 2);
        SBAR(); qkt(pB0, pB1, (bf16*)((char*)K_lds + SHM_K), qr, r32, hi, DQ(jlo + p), nslope, MODE(jlo + p));
        finishSM(pA0, pA1, alA, l_reg, pa0, pa1, pa2, pa3); SBAR();
        SLOAD(SE, tq); SBAR();
        pv_d0(o, vb0, pa0, pa1, pa2, pa3); partialSM(pB0, pB1, m_reg, mnB, alB);
        __syncthreads(); SWAIT(); SWRITE(0, SE);
        RESC(alB); __syncthreads();
        SBAR(); qkt(pA0, pA1, K_lds, qr, r32, hi, DQ(tq), nslope, p + 1 == nreal ? 1 : MODE(tq));
        finishSM(pB0, pB1, alB, l_reg, pa0, pa1, pa2, pa3); SBAR();
        SLOAD(SO, tn); SBAR();
        pv_d0(o, vb0 + (int)SHM_V, pa0, pa1, pa2, pa3); partialSM(pA0, pA1, m_reg, mnA, alA);
        __syncthreads(); SWAIT(); SWRITE(1, SO);
        RESC(alA); __syncthreads();
    }
    finishSM(pA0, pA1, alA, l_reg, pa0, pa1, pa2, pa3); SBAR();
    pv_d0(o, vb0, pa0, pa1, pa2, pa3);
    if (hi == 0) li_l[r32] = l_reg; asm volatile("s_waitcnt lgkmcnt(0)" ::: "memory");
    float rli[16];
#pragma unroll
    for (int r = 0; r < 16; ++r) rli[r] = __builtin_amdgcn_rcpf(li_l[crow(r, hi)]);
    bf16* Ow = Ob + (long)(wid * QBLK) * LDO;
#pragma unroll
    for (int r = 0; r < 16; ++r) { const int orow = crow(r, hi);
#pragma unroll
        for (int d0 = 0; d0 < 4; ++d0) Ow[(long)orow * LDO + d0 * 32 + r32] = (bf16)f2bf(o[d0][r] * rli[r]); }
    __syncthreads();
#undef TI
#undef SLOAD
#undef SWRITE
#undef SWAIT
#undef RESC
#undef DQ
#undef MODE
}
}

__device__ __forceinline__ void p3_attention(Frame& F) {
    const bf16* Z = (const bf16*)(F.ws + WS_Z); bf16* OB = (bf16*)(F.ws + WS_OBUF);
    float gmq = 0.f, gmk = 0.f;
    for (int i = lane_id(); i < 128; i += 64) { gmq = fmaxf(gmq, fabsf(F.in[IN_QG][i])); gmk = fmaxf(gmk, fabsf(F.in[IN_KG][i])); }
#pragma unroll
    for (int o = 1; o < 64; o <<= 1) { gmq = fmaxf(gmq, __shfl_xor(gmq, o)); gmk = fmaxf(gmk, __shfl_xor(gmk, o)); }
    const float thr = 32.f + 2.05f * gmq * gmk * 11.3137085f;
    for (int u = F.vcu; u < 1024; u += F.G) {
        const int rnd = u >> 8, v = u & 255, x = v >> 5, sl = v & 31, qb = sl & 15, vh = sl >> 4, b = rnd, hm = (x + 2 * rnd) & 7, h = hm >> 1, m = hm & 1;
        const float slope = exp2f(-2.f * (float)(h + 1)), nslope = -slope;
        int jlo, nreal;
        { const float dkf = fminf(thr / slope, 100000.f); const int Dk = (int)dkf, q0 = 256 * qb;
          int lo = q0 - 63 - Dk; lo = lo <= 0 ? 0 : (lo + 63) >> 6; int hi_ = (q0 + 255 + Dk) >> 6; hi_ = hi_ > 63 ? 63 : hi_;
          if (((hi_ - lo + 1) & 1) != 0) { if (lo > 0) --lo; else ++hi_; }
          jlo = __builtin_amdgcn_readfirstlane(lo); nreal = __builtin_amdgcn_readfirstlane(hi_ - lo + 1); }
        const unsigned qoff = (unsigned)(((size_t)(b * SEQ + 256 * qb) * NIN + C_DQ + (2 * h + m) * 128) * 2);
        const unsigned kreal = (unsigned)(((size_t)(b * SEQ) * NIN + C_DK + (2 * h + m) * 128) * 2), vreal = (unsigned)(((size_t)(b * SEQ) * NIN + C_DV + h * 256 + vh * 128) * 2);
        const unsigned kmeta = (unsigned)(((size_t)T * NIN + C_DK + (2 * h + m) * 128) * 2), vmeta = (unsigned)(((size_t)T * NIN + C_DV + h * 256 + vh * 128) * 2);
        bf16* Ob = OB + (size_t)(b * SEQ + 256 * qb) * 2048 + m * 1024 + h * 256 + vh * 128;
        att::attn_unit(Z, qoff, kreal, vreal, kmeta, vmeta, Ob, 256 * qb, nslope, jlo, nreal, (char*)F.lds);
    }
}


namespace att2 {
using namespace att;
constexpr int SHM_K2 = 16384, SHM_V2 = 32768;
constexpr int LDS_V = 0, LDS_K = 2 * SHM_V2, LDS_WS = LDS_K + 2 * SHM_K2;
template <int D0> __device__ __forceinline__ void pv_one2(f32x16& od, int vb, bf16x8 pa0, bf16x8 pa1, bf16x8 pa2, bf16x8 pa3) {
    constexpr int IM = (D0 >> 2) * 16384, B = D0 & 3;
    const s16x4 l0 = tr_read<IM + v_rd_off(B, 0, 0)>(vb), h0 = tr_read<IM + v_rd_off(B, 0, 1)>(vb), l1 = tr_read<IM + v_rd_off(B, 1, 0)>(vb), h1 = tr_read<IM + v_rd_off(B, 1, 1)>(vb);
    const s16x4 l2 = tr_read<IM + v_rd_off(B, 2, 0)>(vb), h2 = tr_read<IM + v_rd_off(B, 2, 1)>(vb), l3 = tr_read<IM + v_rd_off(B, 3, 0)>(vb), h3 = tr_read<IM + v_rd_off(B, 3, 1)>(vb);
    asm volatile("s_waitcnt lgkmcnt(0)" ::: "memory"); SBAR();
#define PK(L, H) (bf16x8){L[0], L[1], L[2], L[3], H[0], H[1], H[2], H[3]}
    od = __builtin_amdgcn_mfma_f32_32x32x16_bf16(pa0, PK(l0, h0), od, 0, 0, 0);
    od = __builtin_amdgcn_mfma_f32_32x32x16_bf16(pa1, PK(l1, h1), od, 0, 0, 0);
    od = __builtin_amdgcn_mfma_f32_32x32x16_bf16(pa2, PK(l2, h2), od, 0, 0, 0);
    od = __builtin_amdgcn_mfma_f32_32x32x16_bf16(pa3, PK(l3, h3), od, 0, 0, 0);
#undef PK
}
struct VFrag { s16x4 l0, h0, l1, h1, l2, h2, l3, h3; };
template <int D0> __device__ __forceinline__ void pv_load(VFrag& f, int vb) {
    constexpr int IM = (D0 >> 2) * 16384, B = D0 & 3;
    f.l0 = tr_read<IM + v_rd_off(B, 0, 0)>(vb); f.h0 = tr_read<IM + v_rd_off(B, 0, 1)>(vb); f.l1 = tr_read<IM + v_rd_off(B, 1, 0)>(vb); f.h1 = tr_read<IM + v_rd_off(B, 1, 1)>(vb);
    f.l2 = tr_read<IM + v_rd_off(B, 2, 0)>(vb); f.h2 = tr_read<IM + v_rd_off(B, 2, 1)>(vb); f.l3 = tr_read<IM + v_rd_off(B, 3, 0)>(vb); f.h3 = tr_read<IM + v_rd_off(B, 3, 1)>(vb);
}
__device__ __forceinline__ void pv_mma(f32x16& od, const VFrag& f, bf16x8 pa0, bf16x8 pa1, bf16x8 pa2, bf16x8 pa3) {
#define PK(L, H) (bf16x8){L[0], L[1], L[2], L[3], H[0], H[1], H[2], H[3]}
    od = __builtin_amdgcn_mfma_f32_32x32x16_bf16(pa0, PK(f.l0, f.h0), od, 0, 0, 0);
    od = __builtin_amdgcn_mfma_f32_32x32x16_bf16(pa1, PK(f.l1, f.h1), od, 0, 0, 0);
    od = __builtin_amdgcn_mfma_f32_32x32x16_bf16(pa2, PK(f.l2, f.h2), od, 0, 0, 0);
    od = __builtin_amdgcn_mfma_f32_32x32x16_bf16(pa3, PK(f.l3, f.h3), od, 0, 0, 0);
#undef PK
}
#define PV_WAIT8() do { asm volatile("s_waitcnt lgkmcnt(8)" ::: "memory"); SBAR(); } while (0)
#define PV_WAIT0() do { asm volatile("s_waitcnt lgkmcnt(0)" ::: "memory"); SBAR(); } while (0)
__device__ __forceinline__ void attn_unit2(const bf16* __restrict__ Zb, unsigned qoff, unsigned kreal, unsigned vreal, unsigned kmeta, unsigned vmeta,
                                           bf16* __restrict__ Ob, int q0, float nslope, int jlo, int nreal, bool with_meta, float* __restrict__ lse, char* lds) {
    const __amdgpu_buffer_rsrc_t rs = __builtin_amdgcn_make_buffer_rsrc((void*)Zb, 0, (int)((TM + 64) * (size_t)NIN * 2), 0x00020000);
    int tid = threadIdx.x; asm volatile("" : "+v"(tid));
    const int wid = tid >> 6, lane = tid & 63, r32 = lane & 31, hi = lane >> 5;
    char* V_lds = lds + LDS_V; char* K_lds = lds + LDS_K;
    float* ws = (float*)(lds + LDS_WS) + wid * 64; float* li_l = ws; float* al_l = ws + 32;
    float m_reg = -1e30f, l_reg = 0; f32x16 o[8] = {}; bf16x8 qr[8];
    { const unsigned qo = qoff + (unsigned)((wid * QBLK + r32) * LDK + hi * 8) * 2u;
#pragma unroll
      for (int d0 = 0; d0 < 8; ++d0) qr[d0] = __builtin_bit_cast(bf16x8, __builtin_amdgcn_raw_buffer_load_b128(rs, qo + (unsigned)(d0 * 32), 0, 0)); }
    const float qpos = (float)(q0 + wid * QBLK + r32 - 4 * hi);
    const int vb0 = (int)(uintptr_t)V_lds + v_rd_base(lane);
    const int wu = __builtin_amdgcn_readfirstlane(wid);
    const unsigned kl0 = (unsigned)((lane >> 4) * LDK) * 2u, kc0 = (unsigned)((lane & 15) ^ (lane >> 4));
    const unsigned vl0 = (unsigned)((8 * ((lane >> 4) & 1) + ((lane >> 2) & 3)) * LDK + 32 * (lane >> 5) + 8 * (lane & 3)) * 2u;
    const char* Zc = (const char*)Zb;
#define TI(p) ((p) < nreal ? jlo + (p) : 64)
#define DMA_TILE(jt, b) do { const unsigned ko_ = (jt) < 64 ? kreal + (unsigned)(jt) * (unsigned)(KVBLK * LDK * 2) : kmeta; const unsigned vo_ = (jt) < 64 ? vreal + (unsigned)(jt) * (unsigned)(KVBLK * LDK * 2) : vmeta; \
    _Pragma("unroll") for (int q_ = 0; q_ < 2; ++q_) { const int i_ = 2 * wu + q_; \
        __builtin_amdgcn_global_load_lds((const unsigned*)(Zc + ko_ + (unsigned)(4 * i_ * LDK * 2) + kl0 + ((kc0 ^ (unsigned)((4 * i_) & 15)) << 4)), (LAS unsigned*)(lds + LDS_K + (b) * SHM_K2 + i_ * 1024), 16, 0, 0); \
        const unsigned vu_ = (unsigned)((16 * (i_ >> 2) + 4 * ((i_ >> 1) & 1)) * LDK + 64 * (i_ & 1)) * 2u; \
        __builtin_amdgcn_global_load_lds((const unsigned*)(Zc + vo_ + vu_ + vl0), (LAS unsigned*)(lds + LDS_V + (b) * SHM_V2 + i_ * 1024), 16, 0, 0); \
        __builtin_amdgcn_global_load_lds((const unsigned*)(Zc + vo_ + vu_ + vl0 + 256u), (LAS unsigned*)(lds + LDS_V + (b) * SHM_V2 + 16384 + i_ * 1024), 16, 0, 0); } } while (0)
#define RESC(a) do { if (__any((a) < 1.f)) { if (hi == 0) al_l[r32] = (a); asm volatile("s_waitcnt lgkmcnt(0)" ::: "memory"); \
    _Pragma("unroll") for (int d = 0; d < 8; ++d) _Pragma("unroll") for (int r = 0; r < 16; ++r) o[d][r] *= al_l[crow(r, hi)]; } } while (0)
#define DQ(jt) (qpos - (float)((jt) * KVBLK))
    const int qmin = q0 + QBLK * __builtin_amdgcn_readfirstlane(wid);
#define MODE(jt) ((jt) * KVBLK + KVBLK - 1 <= qmin ? 2 : ((jt) * KVBLK >= qmin + QBLK - 1 ? 3 : 0))
    f32x16 p0, p1; float mn, al; bf16x8 pa0, pa1, pa2, pa3;
    const int NTu = nreal + (with_meta ? 1 : 0);
    DMA_TILE(jlo, 0); asm volatile("s_waitcnt vmcnt(0)" ::: "memory"); __syncthreads();
    for (int p = 0; p < NTu; ++p) {
        const int cur = p & 1, jt = TI(p), jn = TI(p + 1);
        DMA_TILE(jn, cur ^ 1);
        SBAR(); qkt(p0, p1, (const bf16*)(K_lds + cur * SHM_K2), qr, r32, hi, DQ(jt), nslope, p == nreal ? 1 : MODE(jt)); SBAR();
        partialSM(p0, p1, m_reg, mn, al);
        RESC(al);
        finishSM(p0, p1, al, l_reg, pa0, pa1, pa2, pa3); SBAR();
        { const int vb = vb0 + cur * SHM_V2; VFrag fa, fb;
          asm volatile("s_waitcnt lgkmcnt(0)" ::: "memory");
          pv_load<0>(fa, vb);
          pv_load<1>(fb, vb); PV_WAIT8(); pv_mma(o[0], fa, pa0, pa1, pa2, pa3);
          pv_load<2>(fa, vb); PV_WAIT8(); pv_mma(o[1], fb, pa0, pa1, pa2, pa3);
          pv_load<3>(fb, vb); PV_WAIT8(); pv_mma(o[2], fa, pa0, pa1, pa2, pa3);
          pv_load<4>(fa, vb); PV_WAIT8(); pv_mma(o[3], fb, pa0, pa1, pa2, pa3);
          pv_load<5>(fb, vb); PV_WAIT8(); pv_mma(o[4], fa, pa0, pa1, pa2, pa3);
          pv_load<6>(fa, vb); PV_WAIT8(); pv_mma(o[5], fb, pa0, pa1, pa2, pa3);
          pv_load<7>(fb, vb); PV_WAIT8(); pv_mma(o[6], fa, pa0, pa1, pa2, pa3);
          PV_WAIT0(); pv_mma(o[7], fb, pa0, pa1, pa2, pa3); }
        asm volatile("s_waitcnt vmcnt(0)" ::: "memory");
        __syncthreads();
    }
    if (hi == 0) li_l[r32] = l_reg; asm volatile("s_waitcnt lgkmcnt(0)" ::: "memory");
    if (lse != nullptr && hi == 0) lse[(long)(wid * QBLK + r32) * 8] = m_reg * 1.4426950408889634f + __builtin_amdgcn_logf(l_reg);
    float rli[16];
#pragma unroll
    for (int r = 0; r < 16; ++r) rli[r] = __builtin_amdgcn_rcpf(li_l[crow(r, hi)]);
    bf16* Ow = Ob + (long)(wid * QBLK) * LDO;
#pragma unroll
    for (int r = 0; r < 16; ++r) { const int orow = crow(r, hi);
#pragma unroll
        for (int d0 = 0; d0 < 8; ++d0) Ow[(long)orow * LDO + d0 * 32 + r32] = (bf16)f2bf(o[d0][r] * rli[r]); }
    __syncthreads();
#undef TI
#undef DMA_TILE
#undef RESC
#undef DQ
#undef MODE
}
}

__device__ __forceinline__ void p3_attention2(Frame& F, const XcdBarrier& bar) {
    const bf16* Z = (const bf16*)(F.ws + WS_Z); bf16* OB = (bf16*)(F.ws + WS_OBUF);
    float gmq = 0.f, gmk = 0.f;
    for (int i = lane_id(); i < 128; i += 64) { gmq = fmaxf(gmq, fabsf(F.in[IN_QG][i])); gmk = fmaxf(gmk, fabsf(F.in[IN_KG][i])); }
#pragma unroll
    for (int o = 1; o < 64; o <<= 1) { gmq = fmaxf(gmq, __shfl_xor(gmq, o)); gmk = fmaxf(gmk, __shfl_xor(gmk, o)); }
    const float thr = __builtin_bit_cast(float, __builtin_amdgcn_readfirstlane(__builtin_bit_cast(int, 32.f + 2.05f * gmq * gmk * 11.3137085f)));
    float* LSE = (float*)(F.ws + WS_LSE); bf16* OB2 = (bf16*)(F.ws + WS_OBUF2);
    for (int u = F.vcu;; ) {
        int b, h, m, qb, part = -1;
        if (u < 256) { const int x = u >> 5, sl = u & 31, g = 2 * x + (sl >> 4); b = g >> 2; h = 2 + ((g >> 1) & 1); m = g & 1; qb = sl & 15; }
        else {
            __syncthreads();
            if (F.tid == 0) F.MISC[20] = __hip_atomic_fetch_add(F.ctl + CW_ATT, 1u, __ATOMIC_RELAXED, __HIP_MEMORY_SCOPE_AGENT);
            __syncthreads();
            const int t = __builtin_amdgcn_readfirstlane((int)F.MISC[20]);
            if (t >= 384) break;
            if (t < 256) { const int qi = t >> 4, j = t & 15; qb = (qi & 1) ? 8 + (qi >> 1) : 7 - (qi >> 1); b = j >> 2; m = (j >> 1) & 1; part = j & 1; h = 1; }
            else { const int t2 = t - 256, qi = t2 >> 3, j = t2 & 7; qb = (qi & 1) ? 8 + (qi >> 1) : 7 - (qi >> 1); b = j >> 1; m = j & 1; h = 0; }
        }
        const float slope = exp2f(-2.f * (float)(h + 1)), nslope = -slope;
        int jlo, nreal; bool with_meta = true;
        { const float dkf = fminf(thr / slope, 100000.f); const int Dk = (int)dkf, q0 = 256 * qb;
          int lo = q0 - 63 - Dk; lo = lo <= 0 ? 0 : (lo + 63) >> 6; int hi_ = (q0 + 255 + Dk) >> 6; hi_ = hi_ > 63 ? 63 : hi_;
          if (part >= 0) { const int n = hi_ - lo + 1, na = (n + 1) >> 1; if (part == 0) hi_ = lo + na - 1; else { lo = lo + na; with_meta = false; } }
          jlo = __builtin_amdgcn_readfirstlane(lo); nreal = __builtin_amdgcn_readfirstlane(hi_ - lo + 1); }
        const unsigned qoff = (unsigned)(((size_t)(b * SEQ + 256 * qb) * NIN + C_DQ + (2 * h + m) * 128) * 2);
        const unsigned kreal = (unsigned)(((size_t)(b * SEQ) * NIN + C_DK + (2 * h + m) * 128) * 2), vreal = (unsigned)(((size_t)(b * SEQ) * NIN + C_DV + h * 256) * 2);
        const unsigned kmeta = (unsigned)(((size_t)T * NIN + C_DK + (2 * h + m) * 128) * 2), vmeta = (unsigned)(((size_t)T * NIN + C_DV + h * 256) * 2);
        bf16* Ob = (part == 1 ? OB2 : OB) + (size_t)(b * SEQ + 256 * qb) * 2048 + m * 1024 + h * 256;
        float* lsep = part >= 0 ? LSE + ((size_t)part * T + (size_t)(b * SEQ + 256 * qb)) * 8 + m * 4 + h : nullptr;
        att2::attn_unit2(Z, qoff, kreal, vreal, kmeta, vmeta, Ob, 256 * qb, nslope, jlo, nreal, with_meta, lsep, (char*)F.lds);
        if (u < 256 && !(u + F.G < 256)) {
            split_wait(bar, (unsigned*)(F.ctl + CW_KV));
            p3_scan(F);
            split_arrive(bar, (unsigned*)(F.ctl + CW_SC));
            if (F.vcu & 1) p0_experts_q(F, CW_CONV + 256, CONV_SPLIT3, CONV_SPLIT4);
        }
        u = (u < 256 && u + F.G < 256) ? u + F.G : 256;
    }
}

__device__ __forceinline__ void p4_retention(Frame& F) {
    const bf16* Z = (const bf16*)(F.ws + WS_Z); const bf16* KVS = (const bf16*)(F.ws + WS_KVS); bf16* MIX = (bf16*)(F.ws + WS_MIX);
    LAS bf16* R0 = (LAS bf16*)F.lds;
    LAS bf16* R1 = (LAS bf16*)(F.lds + 128 * LDP * 2);
    LAS bf16* R2 = (LAS bf16*)(F.lds + (128 + 256) * LDP * 2);
    LAS float* SS = (LAS float*)(F.lds + (128 + 256 + 128) * LDP * 2);
    for (;;) {
        __syncthreads();
        if (F.tid == 0) F.MISC[21] = __hip_atomic_fetch_add(F.ctl + CW_RET, 1u, __ATOMIC_RELAXED, __HIP_MEMORY_SCOPE_AGENT);
        __syncthreads();
        const int u = __builtin_amdgcn_readfirstlane((int)F.MISC[21]);
        if (u >= 512) break;
        int tid = F.tid, wid = F.wave; asm volatile("" : "+v"(tid)); asm volatile("" : "+s"(wid));
        const int lane = tid & 63, r32 = lane & 31, hi = lane >> 5, wi = wid >> 2, w4 = wid & 3;
        const int bh = u >> 5, c = u & 31, b = bh >> 2, h = bh & 3;
        const size_t row0 = (size_t)b * SEQ + 128 * c;
        const float lgf = log2_gamma(F.in[IN_DECF][h]), lgb = log2_gamma(F.in[IN_DECB][h]);
        const int i_t = tid >> 2, part = tid & 3;
        __syncthreads();
        v4u qw[4];
#pragma unroll
        for (int q = 0; q < 4; ++q) { qw[q] = *(const GAS v4u*)(Z + (row0 + i_t) * NIN + C_RQ + 128 * h + 32 * part + 8 * q);
            const v4u kk = *(const GAS v4u*)(Z + (row0 + i_t) * NIN + C_RK + 128 * h + 32 * part + 8 * q);
            *(LAS v4u*)(R0 + i_t * LDP + 32 * part + 8 * q) = qw[q]; *(LAS v4u*)(R1 + i_t * LDP + 32 * part + 8 * q) = kk; }
        v4u vreg[8], sfr[8], sbr[8];
        { const bf16* vsrc = Z + (row0 + i_t) * NIN + C_RV + 256 * h + part * 64;
          const bf16* Sf = KVS + ((size_t)(bh * 2 + 0) * 32 + c) * 32768; const bf16* Sb = KVS + ((size_t)(bh * 2 + 1) * 32 + c) * 32768;
#pragma unroll
          for (int q = 0; q < 8; ++q) { vreg[q] = *(const GAS v4u*)(vsrc + 8 * q); sfr[q] = *(const GAS v4u*)(Sf + (q * 512 + tid) * 8); sbr[q] = *(const GAS v4u*)(Sb + (q * 512 + tid) * 8); } }
        __syncthreads();
        {
            f32x16 s[2][1]; s[0][0] = (f32x16){}; s[1][0] = (f32x16){};
            lds_mma<2, 1>(s, R0 + (64 * wi) * LDP, LDP, R1 + (32 * w4) * LDP, LDP, 128, lane);
            const int jj = 32 * w4 + r32;
#pragma unroll
            for (int mi = 0; mi < 2; ++mi)
#pragma unroll
                for (int r = 0; r < 16; ++r) { const int ii = 64 * wi + 32 * mi + crow(r, hi);
                    const float dec = jj <= ii ? exp2f(lgf * (float)(ii - jj)) : exp2f(lgb * (float)(jj - ii));
                    R2[ii * LDP + jj] = (bf16)f2bf(s[mi][0][r] * dec); }
        }
        __syncthreads();
#pragma unroll
        for (int q = 0; q < 8; ++q) { const v4u w = vreg[q]; const int c0 = part * 64 + 8 * q;
            R1[(c0 + 0) * LDP + i_t] = (bf16)(w.x & 0xffffu); R1[(c0 + 1) * LDP + i_t] = (bf16)(w.x >> 16);
            R1[(c0 + 2) * LDP + i_t] = (bf16)(w.y & 0xffffu); R1[(c0 + 3) * LDP + i_t] = (bf16)(w.y >> 16);
            R1[(c0 + 4) * LDP + i_t] = (bf16)(w.z & 0xffffu); R1[(c0 + 5) * LDP + i_t] = (bf16)(w.z >> 16);
            R1[(c0 + 6) * LDP + i_t] = (bf16)(w.w & 0xffffu); R1[(c0 + 7) * LDP + i_t] = (bf16)(w.w >> 16); }
        __syncthreads();
        f32x16 acc[2][2];
#pragma unroll
        for (int a = 0; a < 2; ++a)
#pragma unroll
            for (int bb = 0; bb < 2; ++bb) acc[a][bb] = (f32x16){};
        lds_mma<2, 2>(acc, R2 + (64 * wi) * LDP, LDP, R1 + (64 * w4) * LDP, LDP, 128, lane);
        for (int dir = 0; dir < 2; ++dir) {
            __syncthreads();
            const float qd = dir == 0 ? exp2f(lgf * (float)(i_t + 1)) : exp2f(lgb * (float)(128 - i_t));
#pragma unroll
            for (int q = 0; q < 4; ++q) { v4u w; w.x = pk2(bflo(qw[q].x) * qd, bfhi(qw[q].x) * qd); w.y = pk2(bflo(qw[q].y) * qd, bfhi(qw[q].y) * qd);
                w.z = pk2(bflo(qw[q].z) * qd, bfhi(qw[q].z) * qd); w.w = pk2(bflo(qw[q].w) * qd, bfhi(qw[q].w) * qd);
                *(LAS v4u*)(R0 + i_t * LDP + 32 * part + 8 * q) = w; }
#pragma unroll
            for (int q = 0; q < 8; ++q) { const int idx = (q * 512 + tid) * 8; const int e = idx >> 7, d = idx & 127;
                *(LAS v4u*)(R1 + e * LDP + d) = dir == 0 ? sfr[q] : sbr[q]; }
            __syncthreads();
            lds_mma<2, 2>(acc, R0 + (64 * wi) * LDP, LDP, R1 + (64 * w4) * LDP, LDP, 128, lane);
        }
        const f32x4 g0 = *(const GAS f32x4*)(F.in[IN_RETG] + 256 * h + (tid & 31) * 8), g1 = *(const GAS f32x4*)(F.in[IN_RETG] + 256 * h + (tid & 31) * 8 + 4);
        v4u rgw[8];
#pragma unroll
        for (int q = 0; q < 8; ++q) { const int id = q * 512 + tid; rgw[q] = *(const GAS v4u*)(Z + (row0 + (id >> 5)) * NIN + C_RG + 256 * h + (id & 31) * 8); }
#pragma unroll
        for (int mi = 0; mi < 2; ++mi)
#pragma unroll
            for (int r = 0; r < 16; ++r) { float s = acc[mi][0][r] * acc[mi][0][r] + acc[mi][1][r] * acc[mi][1][r];
                s = red_x16(red16(s));
                if (r32 == 0) SS[(64 * wi + 32 * mi + crow(r, hi)) * 4 + w4] = s; }
        __syncthreads();
        if (tid < 128) { const float s = SS[tid * 4] + SS[tid * 4 + 1] + SS[tid * 4 + 2] + SS[tid * 4 + 3]; SS[512 + tid] = 1.f / sqrtf(s * (1.f / 256.f) + EPS); }
        __syncthreads();
        LAS float* OT = (LAS float*)F.lds;
#pragma unroll
        for (int mi = 0; mi < 2; ++mi)
#pragma unroll
            for (int r = 0; r < 16; ++r) { const int ii = 64 * wi + 32 * mi + crow(r, hi); const float rstd = SS[512 + ii];
                OT[ii * LDO_T + 64 * w4 + r32] = acc[mi][0][r] * rstd; OT[ii * LDO_T + 64 * w4 + 32 + r32] = acc[mi][1][r] * rstd; }
        __syncthreads();
#pragma unroll
        for (int q = 0; q < 8; ++q) { const int id = q * 512 + tid, ii = id >> 5, e0 = (id & 31) * 8;
            const f32x4 v0 = *(const LAS f32x4*)(OT + ii * LDO_T + e0), v1 = *(const LAS f32x4*)(OT + ii * LDO_T + e0 + 4);
            const v4u gw = rgw[q];
            const float x[8] = {bflo(gw.x), bfhi(gw.x), bflo(gw.y), bfhi(gw.y), bflo(gw.z), bfhi(gw.z), bflo(gw.w), bfhi(gw.w)};
            const float vv[8] = {v0.x * g0.x, v0.y * g0.y, v0.z * g0.z, v0.w * g0.w, v1.x * g1.x, v1.y * g1.y, v1.z * g1.z, v1.w * g1.w};
            float o[8];
#pragma unroll
            for (int e = 0; e < 8; ++e) o[e] = vv[e] * x[e] * __builtin_amdgcn_rcpf(1.f + __builtin_amdgcn_exp2f(-1.4426950408889634f * x[e]));
            v4u w; w.x = pk2(o[0], o[1]); w.y = pk2(o[2], o[3]); w.z = pk2(o[4], o[5]); w.w = pk2(o[6], o[7]);
            *(GAS v4u*)(MIX + (row0 + ii) * DM + 256 * h + e0) = w; }
    }
    __syncthreads();
}
__device__ __forceinline__ void p4_attn_post(Frame& F) {
    const bf16* OB = (const bf16*)(F.ws + WS_OBUF); bf16* MIX = (bf16*)(F.ws + WS_MIX);
    int lane = lane_id(); asm volatile("" : "+v"(lane));
    const int gw = F.vcu * NWAVES + F.wave, NGW = F.G * NWAVES;
    float a = 0.f, bsum = 0.f;
    for (int i = lane; i < 128; i += 64) { a += F.in[IN_LQ1][i] * F.in[IN_LK1][i]; bsum += F.in[IN_LQ2][i] * F.in[IN_LK2][i]; }
    const float lam = expf(wave_sum(a)) - expf(wave_sum(bsum)) + LAM_INIT;
    for (int m = gw; m < T; m += NGW) {
        const GAS v2u* o1 = (const GAS v2u*)(OB + (size_t)m * 2048) + lane;
        const GAS v2u* o2 = (const GAS v2u*)(OB + (size_t)m * 2048 + 1024) + lane;
        const GAS f32x4* gp = (const GAS f32x4*)F.in[IN_DOG] + lane;
        GAS v2u* op = (GAS v2u*)(MIX + (size_t)m * DM + 1024) + lane;
#pragma unroll
        for (int h = 0; h < 4; ++h) { const v2u w1 = o1[64 * h], w2 = o2[64 * h]; const f32x4 g = gp[64 * h];
            f32x4 x1 = (f32x4){bflo(w1.x), bfhi(w1.x), bflo(w1.y), bfhi(w1.y)}, x2 = (f32x4){bflo(w2.x), bfhi(w2.x), bflo(w2.y), bfhi(w2.y)};
#if ATT_V2
            if (h == 1) {
                const bf16* OB2 = (const bf16*)(F.ws + WS_OBUF2); const float* LSE = (const float*)(F.ws + WS_LSE);
                const v2u u1 = *((const GAS v2u*)(OB2 + (size_t)m * 2048) + lane + 64 * h), u2 = *((const GAS v2u*)(OB2 + (size_t)m * 2048 + 1024) + lane + 64 * h);
                const f32x4 y1 = (f32x4){bflo(u1.x), bfhi(u1.x), bflo(u1.y), bfhi(u1.y)}, y2 = (f32x4){bflo(u2.x), bfhi(u2.x), bflo(u2.y), bfhi(u2.y)};
                const float la1 = LSE[(size_t)m * 8 + 0 * 4 + 1], lb1 = LSE[((size_t)T + m) * 8 + 0 * 4 + 1], la2 = LSE[(size_t)m * 8 + 1 * 4 + 1], lb2 = LSE[((size_t)T + m) * 8 + 1 * 4 + 1];
                const float wa1 = __builtin_amdgcn_rcpf(1.f + __builtin_amdgcn_exp2f(lb1 - la1)), wa2 = __builtin_amdgcn_rcpf(1.f + __builtin_amdgcn_exp2f(lb2 - la2));
                x1 = x1 * wa1 + y1 * (1.f - wa1); x2 = x2 * wa2 + y2 * (1.f - wa2);
            }
#endif
            const f32x4 v = x1 - x2 * lam; const float s = wave_sum((v.x * v.x + v.y * v.y) + (v.z * v.z + v.w * v.w));
            const float rstd = (1.f - LAM_INIT) / sqrtf(s * (1.f / 256.f) + EPS);
            v2u w; w.x = pk2(v.x * rstd * g.x, v.y * rstd * g.y); w.y = pk2(v.z * rstd * g.z, v.w * rstd * g.w); op[64 * h] = w; }
    }
}

__device__ __forceinline__ void p6_route(Frame& F) {
    const bf16* H1 = (const bf16*)(F.ws + WS_U); unsigned char* XT = F.ws + WS_XT;
    int* TOK = (int*)(F.ws + WS_TOK); float* GATE = (float*)(F.ws + WS_GATE); float* RS = (float*)(F.ws + WS_RS); int* SLOT = (int*)(F.ws + WS_SLOT);
    LAS float* part = (LAS float*)F.lds;
    LAS float* ssqp = (LAS float*)(F.lds + 2 * 4 * 32 * 33 * 4);
    const float* wr_ = F.in[IN_WR]; const float* gain = F.in[IN_FNG];
    for (int u = F.vcu; u < T / 64; u += F.G) {
        int tid = F.tid, wid = F.wave; asm volatile("" : "+v"(tid)); asm volatile("" : "+s"(wid));
        const int lane = tid & 63, bl = wid >> 2, kq = wid & 3, i = lane & 31, kk = lane >> 5;
        const int row = u * 64 + bl * 32 + i;
        const bf16* hrow = H1 + (size_t)row * DM;
        f32x16 acc = (f32x16){}; float ssq = 0.f;
#pragma unroll 4
        for (int it = 0; it < 32; ++it) {
            const int k = 512 * kq + 16 * it + 8 * kk;
            const v4u hw = *(const GAS v4u*)(hrow + k);
            const f32x4 h0 = (f32x4){bflo(hw.x), bfhi(hw.x), bflo(hw.y), bfhi(hw.y)}, h1 = (f32x4){bflo(hw.z), bfhi(hw.z), bflo(hw.w), bfhi(hw.w)};
            const f32x4 g0 = *(const GAS f32x4*)(gain + k), g1 = *(const GAS f32x4*)(gain + k + 4);
            const f32x4 a0 = h0 * g0, a1 = h1 * g1;
            ssq += (h0.x * h0.x + h0.y * h0.y) + (h0.z * h0.z + h0.w * h0.w) + (h1.x * h1.x + h1.y * h1.y) + (h1.z * h1.z + h1.w * h1.w);
#if MOE_FP8
            { v2u w; w.x = pk4_fp8(a0.x * FP8_SX, a0.y * FP8_SX, a0.z * FP8_SX, a0.w * FP8_SX); w.y = pk4_fp8(a1.x * FP8_SX, a1.y * FP8_SX, a1.z * FP8_SX, a1.w * FP8_SX);
              *(GAS v2u*)(XT + (size_t)row * DM + k) = w; }
#else
            { v4u w; w.x = pk2(a0.x, a0.y); w.y = pk2(a0.z, a0.w); w.z = pk2(a1.x, a1.y); w.w = pk2(a1.z, a1.w);
              *(GAS v4u*)(XT + ((size_t)row * DM + k) * 2) = w; }
#endif
            const float av[8] = {a0.x, a0.y, a0.z, a0.w, a1.x, a1.y, a1.z, a1.w};
#pragma unroll
            for (int e = 0; e < 8; ++e) { const float bw = wr_[(size_t)(k + e) * NE + i]; acc = __builtin_amdgcn_mfma_f32_32x32x2f32(av[e], bw, acc, 0, 0, 0); }
        }
        ssq = red_x32(ssq);
        __syncthreads();
#pragma unroll
        for (int r = 0; r < 16; ++r) part[((bl * 4 + kq) * 32 + crow(r, kk)) * 33 + i] = acc[r];
        if (kk == 0) ssqp[(bl * 4 + kq) * 32 + i] = ssq;
        __syncthreads();
        if (tid < 64) {
            const int b2 = tid >> 5, ii = tid & 31, tokn = u * 64 + tid;
            const float sq = ssqp[(b2 * 4 + 0) * 32 + ii] + ssqp[(b2 * 4 + 1) * 32 + ii] + ssqp[(b2 * 4 + 2) * 32 + ii] + ssqp[(b2 * 4 + 3) * 32 + ii];
            const float rstd = 1.f / sqrtf(sq * (1.f / DM) + EPS);
            float lg[NE];
#pragma unroll
            for (int e = 0; e < NE; ++e) { const float s = part[((b2 * 4 + 0) * 32 + ii) * 33 + e] + part[((b2 * 4 + 1) * 32 + ii) * 33 + e] + part[((b2 * 4 + 2) * 32 + ii) * 33 + e] + part[((b2 * 4 + 3) * 32 + ii) * 33 + e];
                lg[e] = s * rstd + F.in[IN_BR][e]; }
            int sel[TOPK]; float val[TOPK]; unsigned used = 0u;
#pragma unroll
            for (int k = 0; k < TOPK; ++k) { float best = -3.0e38f; int bi = 0;
#pragma unroll
                for (int e = 0; e < NE; ++e) { const bool ok = !((used >> e) & 1u) && lg[e] > best; best = ok ? lg[e] : best; bi = ok ? e : bi; }
                sel[k] = bi; val[k] = best; used |= 1u << bi; }
            float ex[TOPK], den = 0.f;
#pragma unroll
            for (int k = 0; k < TOPK; ++k) { ex[k] = expf(val[k] - val[0]); den += ex[k]; }
            LAS unsigned* cntl = (LAS unsigned*)(F.lds + 40960);
            if (tid < NE) cntl[tid] = 0u;
            asm volatile("s_waitcnt lgkmcnt(0)" ::: "memory");
            unsigned lp[TOPK];
#pragma unroll
            for (int k = 0; k < TOPK; ++k) lp[k] = __hip_atomic_fetch_add(cntl + sel[k], 1u, __ATOMIC_RELAXED, __HIP_MEMORY_SCOPE_WORKGROUP);
            asm volatile("s_waitcnt lgkmcnt(0)" ::: "memory");
            if (tid < NE) { const unsigned n = cntl[tid]; cntl[NE + tid] = n ? __hip_atomic_fetch_add(F.ctl + CW_CNT + 64 * tid, n, __ATOMIC_RELAXED, __HIP_MEMORY_SCOPE_AGENT) : 0u; }
            asm volatile("s_waitcnt vmcnt(0) lgkmcnt(0)" ::: "memory");
#pragma unroll
            for (int k = 0; k < TOPK; ++k) { const int e = sel[k];
                const unsigned pos = cntl[NE + e] + lp[k];
                const size_t s = (size_t)e * ECAP + pos;
                TOK[s] = tokn; GATE[s] = ex[k] / den; RS[s] = rstd; SLOT[tokn * 4 + k] = (int)s; }
        }
    }
    __syncthreads();
}
__device__ __forceinline__ void p9_combine(Frame& F) {
    MoeTab tb = moe_tab(F);
    const int* SLOT = (const int*)(F.ws + WS_SLOT);
    int lane = lane_id(); asm volatile("" : "+v"(lane));
    const int gw = F.vcu * NWAVES + F.wave, NGW = F.G * NWAVES;
#if Y_FP8
    const unsigned char* Y = F.ws + WS_Y;
    int sc[4];
#pragma unroll
    for (int k = 0; k < 4; ++k) sc[k] = gw < T ? SLOT[gw * 4 + k] : 0;
    for (int m = gw; m < T; m += NGW) {
        size_t yr[4];
#pragma unroll
        for (int k = 0; k < 4; ++k) { const int s = sc[k]; const int e = s / ECAP, pos = s % ECAP; yr[k] = (size_t)(tb.rbase[e] + pos) * DM; }
        float* op = F.out + (size_t)m * DM; const bf16* hp = (const bf16*)(F.ws + WS_U) + (size_t)m * DM;
        v4u w[2][4], hh[2][2];
#pragma unroll
        for (int j = 0; j < 2; ++j) { const int col = 1024 * j + 16 * lane;
#pragma unroll
            for (int k = 0; k < 4; ++k) w[j][k] = *(const GAS v4u*)(Y + yr[k] + col);
            hh[j][0] = *(const GAS v4u*)(hp + col); hh[j][1] = *(const GAS v4u*)(hp + col + 8); }
        { const int mn = m + NGW < T ? m + NGW : m;
#pragma unroll
          for (int k = 0; k < 4; ++k) sc[k] = SLOT[mn * 4 + k]; }
#pragma unroll
        for (int j = 0; j < 2; ++j) { const int col = 1024 * j + 16 * lane;
            f32x4 a[4];
            { const v4u h0 = hh[j][0], h1 = hh[j][1];
              a[0] = (f32x4){bflo(h0.x), bfhi(h0.x), bflo(h0.y), bfhi(h0.y)}; a[1] = (f32x4){bflo(h0.z), bfhi(h0.z), bflo(h0.w), bfhi(h0.w)};
              a[2] = (f32x4){bflo(h1.x), bfhi(h1.x), bflo(h1.y), bfhi(h1.y)}; a[3] = (f32x4){bflo(h1.z), bfhi(h1.z), bflo(h1.w), bfhi(h1.w)}; }
            float acc[16];
#pragma unroll
            for (int i = 0; i < 16; ++i) acc[i] = 0.f;
#pragma unroll
            for (int k = 0; k < 4; ++k) { const unsigned ww[4] = {w[j][k].x, w[j][k].y, w[j][k].z, w[j][k].w};
#pragma unroll
                for (int q = 0; q < 4; ++q) { const f32x2 lo = __builtin_amdgcn_cvt_pk_f32_fp8(ww[q], false), hi = __builtin_amdgcn_cvt_pk_f32_fp8(ww[q], true);
                    acc[4 * q] += lo.x; acc[4 * q + 1] += lo.y; acc[4 * q + 2] += hi.x; acc[4 * q + 3] += hi.y; } }
#pragma unroll
            for (int q = 0; q < 4; ++q) { f32x4 o = a[q]; o.x += acc[4 * q] * (1.f / FP8_SY); o.y += acc[4 * q + 1] * (1.f / FP8_SY); o.z += acc[4 * q + 2] * (1.f / FP8_SY); o.w += acc[4 * q + 3] * (1.f / FP8_SY);
                *(GAS f32x4*)(op + col + 4 * q) = o; } }
    }
#else
    const bf16* Y = (const bf16*)(F.ws + WS_Y);
    for (int m = gw; m < T; m += NGW) {
        size_t yr[4];
#pragma unroll
        for (int k = 0; k < 4; ++k) { const int s = SLOT[m * 4 + k]; const int e = s / ECAP, pos = s % ECAP; yr[k] = (size_t)(tb.rbase[e] + pos) * DM; }
        float* op = F.out + (size_t)m * DM;
#pragma unroll
        for (int j = 0; j < 4; ++j) { const int col = 512 * j + 8 * lane;
            f32x4 a0 = *(const GAS f32x4*)(op + col), a1 = *(const GAS f32x4*)(op + col + 4);
#pragma unroll
            for (int k = 0; k < 4; ++k) { const v4u w = *(const GAS v4u*)(Y + yr[k] + col);
                a0.x += bflo(w.x); a0.y += bfhi(w.x); a0.z += bflo(w.y); a0.w += bfhi(w.y); a1.x += bflo(w.z); a1.y += bfhi(w.z); a1.z += bflo(w.w); a1.w += bfhi(w.w); }
            *(GAS f32x4*)(op + col) = a0; *(GAS f32x4*)(op + col + 4) = a1; }
    }
#endif
}

struct Args { const float* in[22]; float* out; unsigned char* ws; int ph_lo, ph_hi; };
__global__ void __launch_bounds__(NWAVES * 64, 2) fwd(Args args) {
    extern __shared__ __attribute__((aligned(16))) unsigned char lds[];
    Frame F;
    F.lds = (LAS unsigned char*)lds;
    F.MISC = (volatile LAS unsigned*)(F.lds + MISC_OFF);
    F.tid = threadIdx.x; F.wave = __builtin_amdgcn_readfirstlane(F.tid >> 6);
    F.G = gridDim.x; { const int bx = blockIdx.x; F.vcu = (F.G % 8 == 0) ? (bx % 8) * (F.G / 8) + bx / 8 : bx; }
    F.ws = args.ws; F.ctl = (gu32*)(args.ws + WS_CTL); F.out = args.out;
#pragma unroll
    for (int i = 0; i < 22; ++i) F.in[i] = args.in[i];
    for (int u = F.tid; u < (LDS_BYTES - MISC_OFF) / 4; u += NWAVES * 64) ((LAS unsigned*)(F.lds + MISC_OFF))[u] = 0u;
    __syncthreads();
    const int lo = args.ph_lo, hi = args.ph_hi;
    XcdBarrier bar; bar.bar = (unsigned*)(F.ctl + CW_BAR); bar.x = 0; bar.st = nullptr;
    if (hi - lo > 1) bar = xcd_barrier_post((unsigned*)(F.ctl + CW_BAR), F.MISC + 8);
#ifndef PHASE_MASK
#define PHASE_MASK 0x3ff
#endif
#define IN(k) (((PHASE_MASK >> (k)) & 1) && lo <= (k) && (k) < hi)
#define BOTH(k) (IN(k) && IN((k) + 1))
#define GRID_BAR() xcd_barrier(bar)
#ifndef PROBE_DUP
#define PROBE_DUP 0
#endif
#define DUP(k) ((PROBE_DUP >> (k)) & 1)

    if (IN(0)) { p0_prologue(F); if (BOTH(0)) GRID_BAR(); }
    if (IN(1)) {
        p1_meta_rows(F);
        if ((F.vcu & 31) < NCONV) p0_experts_q(F, CW_CONV, 0, CONV_SPLIT);
        QueueSched S{(const bf16*)(F.ws + WS_U), (const bf16*)(F.ws + WS_WIN), T / 2048, NIN / 256, DM * 2, (int)(blockIdx.x & 7), F.ctl + CW_Q1, (volatile LAS int*)(F.MISC + 16)};
        EpiZ E{(bf16*)(F.ws + WS_Z), F.in[IN_QG], F.in[IN_KG], (LAS float*)(F.lds + 131072)};
        pg8::gemm_phase<EpiZ, QueueSched, false, false>(F.lds, DM * 2, S, E);
        split_arrive(bar, (unsigned*)(F.ctl + CW_P1));
        p0_experts_q(F, CW_CONV + 64, CONV_SPLIT, CONV_SPLIT2);
    }
    if (IN(2)) { }
    if (IN(3)) {
        if (!(F.vcu & 1)) p0_experts_q(F, CW_CONV + 192, CONV_SPLIT2, CONV_SPLIT3);
        split_wait(bar, (unsigned*)(F.ctl + CW_P1));
        p2_kvstates(F);
        split_arrive(bar, (unsigned*)(F.ctl + CW_KV));
#ifndef NO_ATT
#if ATT_V2
        p3_attention2(F, bar);
        split_arrive(bar, (unsigned*)(F.ctl + CW_AT));
#else
        p3_attention(F); if (DUP(3)) p3_attention(F);
#endif
#endif
 }
    if (IN(4)) {
        split_wait(bar, (unsigned*)(F.ctl + CW_SC));
        p4_retention(F);
        p0_experts_q(F, CW_CONV + 128, CONV_SPLIT4, CONV_TICKETS);
        split_wait(bar, (unsigned*)(F.ctl + CW_AT));
        p4_attn_post(F);
 if (BOTH(4)) GRID_BAR(); }
    if (IN(5)) {
        DenseSched S{(const bf16*)(F.ws + WS_MIX), (const bf16*)(F.ws + WS_WOUT), T / 256, DM / 256, DM * 2, F.G, (int)blockIdx.x};
        EpiOut E{F.in[IN_X], (bf16*)(F.ws + WS_U)};
        pg8::gemm_phase<EpiOut, DenseSched, false, false>(F.lds, DM * 2, S, E); if (DUP(5)) pg8::gemm_phase<EpiOut, DenseSched, false, false>(F.lds, DM * 2, S, E);
        if (BOTH(5)) GRID_BAR();
    }
    if (IN(6)) { p6_route(F); if (BOTH(6)) GRID_BAR(); }
    if (IN(7)) {
        moe_build_tables(F);
        MoeTab tb = moe_tab(F);
        constexpr int EB = MOE_FP8 ? 1 : 2;
        MoeSched S{F.ws + WS_XT, F.ws + WS_WGU, (size_t)4096 * DM * EB, 16, DM * EB, F.G, (int)blockIdx.x, tb, (const int*)(F.ws + WS_TOK)};
        EpiAct E{F.ws + WS_ACT, F.in[IN_BGU], (const float*)(F.ws + WS_RS), tb, F.lds};
        pg8::gemm_phase<EpiAct, MoeSched, true, MOE_FP8 != 0>(F.lds, DM * EB, S, E); if (DUP(7)) pg8::gemm_phase<EpiAct, MoeSched, true, MOE_FP8 != 0>(F.lds, DM * EB, S, E);
        if (BOTH(7)) GRID_BAR();
    }
    if (IN(8)) {
        if (!IN(7)) moe_build_tables(F);
        MoeTab tb = moe_tab(F);
        constexpr int EB = MOE_FP8 ? 1 : 2;
        MoeSched S{F.ws + WS_ACT, F.ws + WS_WD, (size_t)DM * DFF * EB, 8, DFF * EB, F.G, (int)blockIdx.x, tb, nullptr};
        EpiY E{F.ws + WS_Y, F.in[IN_BD], (const float*)(F.ws + WS_GATE), tb, F.lds};
        pg8::gemm_phase<EpiY, MoeSched, false, MOE_FP8 != 0>(F.lds, DFF * EB, S, E); if (DUP(8)) pg8::gemm_phase<EpiY, MoeSched, false, MOE_FP8 != 0>(F.lds, DFF * EB, S, E);
        if (BOTH(8)) GRID_BAR();
    }
    if (IN(9)) { if (!IN(8)) moe_build_tables(F); p9_combine(F); }
#undef IN
#undef BOTH
#undef GRID_BAR
}

extern "C" void kernel_launch(void* const* d_in, const int* in_sizes, int n_in, void* d_out, int out_size, void* d_ws, size_t ws_size, hipStream_t stream) {
    static int grid = 0;
    if (grid == 0) {
        if (n_in != 22 || out_size != T * DM || ws_size < WS_END) { fprintf(stderr, "kernel_launch: unexpected shapes (n_in %d out %d ws %zu)\n", n_in, out_size, ws_size); grid = -1; return; }
        int dev = 0, cus = 0;
        if (hipGetDevice(&dev) != hipSuccess || hipDeviceGetAttribute(&cus, hipDeviceAttributeMultiprocessorCount, dev) != hipSuccess) { grid = -1; return; }
        if (hipFuncSetAttribute((const void*)fwd, hipFuncAttributeMaxDynamicSharedMemorySize, LDS_BYTES) != hipSuccess) { fprintf(stderr, "kernel_launch: hipFuncSetAttribute failed\n"); grid = -1; return; }
        int per_cu = 0;
        if (hipOccupancyMaxActiveBlocksPerMultiprocessor(&per_cu, (const void*)fwd, NWAVES * 64, LDS_BYTES) != hipSuccess || per_cu < 1) fprintf(stderr, "kernel_launch: occupancy query says %d\n", per_cu);
        (void)hipGetLastError();
        grid = cus;
    }
    if (grid < 0) return;
    (void)hipMemsetAsync((char*)d_ws + WS_CTL, 0, CTL_ZERO_BYTES, stream);
    Args a{};
    for (int i = 0; i < 22; ++i) a.in[i] = (const float*)d_in[i];
    a.out = (float*)d_out; a.ws = (unsigned char*)d_ws;
#if MK_SPLIT
    for (int p = 0; p < NPHASE; ++p) { a.ph_lo = p; a.ph_hi = p + 1; hipLaunchKernelGGL(fwd, dim3(grid), dim3(NWAVES * 64), LDS_BYTES, stream, a); }
#else
    a.ph_lo = 0; a.ph_hi = NPHASE; hipLaunchKernelGGL(fwd, dim3(grid), dim3(NWAVES * 64), LDS_BYTES, stream, a);
#endif
    const hipError_t le = hipPeekAtLastError();
    if (le != hipSuccess) fprintf(stderr, "kernel_launch: launch failed: %s\n", hipGetErrorName(le));
}
```
